# Optimizing an MI355X kernel written in HIP

```python
import jax, jax.numpy as jnp
from jax import lax
import numpy as np

D_MODEL = 2048
BATCH = 4
SEQ = 8192
DEPTH = 1

MEM_LEN = 256
HGRN_WIDTH = D_MODEL // 2
HGRN_HEADS = 8
HGRN_KDIM = HGRN_WIDTH // HGRN_HEADS
HGRN_VDIM = HGRN_WIDTH // HGRN_HEADS
CONV_CH = D_MODEL - HGRN_WIDTH
CONV_GROUPS = 8
SHORT_CONV_K = 3
IN_COLS = 4 * HGRN_WIDTH + 3 * CONV_CH
CHUNK = 64
MEM_HEADS = 4
MEM_HEAD_DIM = D_MODEL // MEM_HEADS
D_FF = 5632
FFN_CONV_K = 3
EPS = 1e-6

kernel_name = "hgrn2_shortconv_hybrid_block"


def rmsnorm(x, w):
    xf = x.astype(jnp.float32)
    y = xf * lax.rsqrt(jnp.mean(xf * xf, axis=-1, keepdims=True) + EPS)
    return (y * w.astype(jnp.float32)).astype(x.dtype)


def causal_dwconv(x, w):
    k = w.shape[0]
    s = x.shape[1]
    xp = jnp.pad(x, ((0, 0), (k - 1, 0), (0, 0)))
    y = xp[:, 0:s] * w[0]
    for j in range(1, k):
        y = y + xp[:, j:j + s] * w[j]
    return y


def hgrn2_chunked(q, k, v, logf):
    bb, s, h, kd = q.shape
    vd = v.shape[-1]
    n = s // CHUNK

    def to_chunks(t):
        return t.reshape(bb, n, CHUNK, h, t.shape[-1]).transpose(1, 0, 3, 2, 4)

    qc, kc, vc, gc = to_chunks(q), to_chunks(k), to_chunks(v), to_chunks(logf)
    causal = jnp.tril(jnp.ones((CHUNK, CHUNK), dtype=bool))

    def step(state, inp):
        q_, k_, v_, g_ = inp
        b = jnp.cumsum(g_, axis=2)
        o_inter = jnp.einsum('bhtk,bhkv->bhtv', q_ * jnp.exp(b), state)
        diff = b[:, :, :, None, :] - b[:, :, None, :, :]
        decay = jnp.exp(jnp.where(causal[:, :, None], diff, -jnp.inf))
        scores = jnp.einsum('bhtk,bhtsk,bhsk->bhts', q_, decay, k_)
        o = o_inter + jnp.einsum('bhts,bhsv->bhtv', scores, v_)
        b_last = b[:, :, -1:, :]
        new_state = (jnp.exp(b_last[:, :, 0, :])[..., None] * state
                     + jnp.einsum('bhsk,bhsv->bhkv', k_ * jnp.exp(b_last - b), v_))
        return new_state, o

    s0 = jnp.zeros((bb, h, kd, vd), jnp.float32)
    _, o = lax.scan(step, s0, (qc, kc, vc, gc))
    return o.transpose(1, 0, 3, 2, 4).reshape(bb, s, h, vd)


def hybrid_mixer(h, w_in, lb, hgrn_norm_w, sconv_w, w_out):
    bb, s, _ = h.shape
    proj = h @ w_in
    W, C = HGRN_WIDTH, CONV_CH
    splits = [W, 2 * W, 3 * W, 4 * W, 4 * W + C, 4 * W + 2 * C]
    q, f_pre, i_in, g, cb, cc, ch = jnp.split(proj, splits, axis=-1)

    f = lb + (1.0 - lb) * jax.nn.sigmoid(f_pre.astype(jnp.float32))
    logf = jnp.log(f)
    k = 1.0 - f
    qf = jax.nn.silu(q.astype(jnp.float32))
    heads = lambda t, d: t.reshape(bb, s, HGRN_HEADS, d)
    o = hgrn2_chunked(heads(qf, HGRN_KDIM), heads(k, HGRN_KDIM),
                      heads(i_in.astype(jnp.float32), HGRN_VDIM), heads(logf, HGRN_KDIM))
    o = rmsnorm(o, hgrn_norm_w).reshape(bb, s, W).astype(h.dtype)
    o = o * jax.nn.silu(g)

    y = cb * causal_dwconv(cc * ch, sconv_w)

    return jnp.concatenate([o, y], axis=-1) @ w_out


def memory_cross_attention(h, mem_n, wq, wk, wv, wo):
    bb, s, _ = h.shape
    m = mem_n.shape[1]
    q = (h @ wq).reshape(bb, s, MEM_HEADS, MEM_HEAD_DIM)
    k = (mem_n @ wk).reshape(bb, m, MEM_HEADS, MEM_HEAD_DIM)
    v = (mem_n @ wv).reshape(bb, m, MEM_HEADS, MEM_HEAD_DIM)
    sc = jnp.einsum('bqhd,bmhd->bhqm', q, k).astype(jnp.float32) * (MEM_HEAD_DIM ** -0.5)
    p = jax.nn.softmax(sc, axis=-1).astype(v.dtype)
    o = jnp.einsum('bhqm,bmhd->bqhd', p, v).reshape(bb, s, D_MODEL)
    return o @ wo


def conv_ffn(h, w_gate, w_up, conv_w, conv_b, w_down):
    a = causal_dwconv(h @ w_gate, conv_w) + conv_b
    return (jax.nn.silu(a) * (h @ w_up)) @ w_down


def setup_inputs(seed: int = 0) -> dict:
    key = jax.random.key(seed)
    ks = jax.random.split(key, 24)
    f32 = jnp.float32
    nrm = lambda k, shape, scale: jax.random.normal(k, shape, f32) * scale
    gain = lambda k, shape: 1.0 + 0.02 * jax.random.normal(k, shape, f32)
    L = DEPTH
    return {
        "x": nrm(ks[0], (BATCH, SEQ, D_MODEL), 1.0),
        "mem": nrm(ks[1], (BATCH, MEM_LEN, D_MODEL), 1.0),
        "hgrn_lb": nrm(ks[2], (DEPTH + 1, HGRN_WIDTH), 0.1),
        "norm1_w": gain(ks[3], (L, D_MODEL)),
        "w_in": nrm(ks[4], (L, D_MODEL, IN_COLS), D_MODEL ** -0.5),
        "hgrn_norm_w": gain(ks[5], (L, HGRN_VDIM)),
        "sconv_w": nrm(ks[6], (L, SHORT_CONV_K, CONV_CH), SHORT_CONV_K ** -0.5),
        "w_out": nrm(ks[7], (L, D_MODEL, D_MODEL), D_MODEL ** -0.5),
        "norm2_w": gain(ks[8], (L, D_MODEL)),
        "mem_norm_w": gain(ks[9], (L, D_MODEL)),
        "wq": nrm(ks[10], (L, D_MODEL, D_MODEL), D_MODEL ** -0.5),
        "wk": nrm(ks[11], (L, D_MODEL, D_MODEL), D_MODEL ** -0.5),
        "wv": nrm(ks[12], (L, D_MODEL, D_MODEL), D_MODEL ** -0.5),
        "wo": nrm(ks[13], (L, D_MODEL, D_MODEL), D_MODEL ** -0.5),
        "norm3_w": gain(ks[14], (L, D_MODEL)),
        "w_gate": nrm(ks[15], (L, D_MODEL, D_FF), D_MODEL ** -0.5),
        "w_up": nrm(ks[16], (L, D_MODEL, D_FF), D_MODEL ** -0.5),
        "ffn_conv_w": nrm(ks[17], (L, FFN_CONV_K, D_FF), FFN_CONV_K ** -0.5),
        "ffn_conv_b": nrm(ks[18], (L, D_FF), 0.02),
        "w_down": nrm(ks[19], (L, D_FF, D_MODEL), D_FF ** -0.5),
        "final_norm_w": gain(ks[20], (D_MODEL,)),
    }


def reference(x, mem, hgrn_lb, norm1_w, w_in, hgrn_norm_w, sconv_w, w_out,
              norm2_w, mem_norm_w, wq, wk, wv, wo, norm3_w, w_gate, w_up,
              ffn_conv_w, ffn_conv_b, w_down, final_norm_w):
    lb_table = jnp.cumsum(jax.nn.softmax(hgrn_lb.astype(jnp.float32), axis=0), axis=0)
    for l in range(DEPTH):
        h = rmsnorm(x, norm1_w[l])
        x = x + hybrid_mixer(h, w_in[l], lb_table[l], hgrn_norm_w[l], sconv_w[l], w_out[l])
        h = rmsnorm(x, norm2_w[l])
        mem_n = rmsnorm(mem, mem_norm_w[l])
        x = x + memory_cross_attention(h, mem_n, wq[l], wk[l], wv[l], wo[l])
        h = rmsnorm(x, norm3_w[l])
        x = x + conv_ffn(h, w_gate[l], w_up[l], ffn_conv_w[l], ffn_conv_b[l], w_down[l])
    return rmsnorm(x, final_norm_w)
```

```cpp
#include <hip/hip_runtime.h>
#include <hip/hip_cooperative_groups.h>
#include <cstdio>
namespace cg = cooperative_groups;

#ifndef MULTI_LAUNCH
#define MULTI_LAUNCH 0
#endif

#ifndef ONLY_PHASE
#define ONLY_PHASE -1
#endif
#define PH_ON(k) (ONLY_PHASE < 0 || ONLY_PHASE == (k))

#define LAS __attribute__((address_space(3)))
typedef unsigned short bf16_t;
typedef short bf16x8 __attribute__((ext_vector_type(8)));
typedef float f32x4 __attribute__((ext_vector_type(4)));
typedef float f32x2 __attribute__((ext_vector_type(2)));
typedef unsigned u32x4 __attribute__((ext_vector_type(4)));
typedef unsigned u32x2 __attribute__((ext_vector_type(2)));

constexpr int T = 32768, D = 2048, SEQ = 8192;
constexpr int INC = 7168, PJ = 6144;
constexpr int FF = 5632;
constexpr float EPS = 1e-6f;
constexpr int NPHASE = 12;

constexpr size_t SZ_TD2 = (size_t)T * D * 2;
constexpr size_t WS_WIN = 0;
constexpr size_t WS_WOUT = WS_WIN + (size_t)INC * D * 2;
constexpr size_t WS_WQ = WS_WOUT + (size_t)D * D * 2;
constexpr size_t WS_WK = WS_WQ + (size_t)D * D * 2;
constexpr size_t WS_WV = WS_WK + (size_t)D * D * 2;
constexpr size_t WS_WO = WS_WV + (size_t)D * D * 2;
constexpr size_t WS_H = WS_WO + (size_t)D * D * 2;
constexpr size_t WS_B0 = WS_H + SZ_TD2;
constexpr size_t WS_B1 = WS_B0 + SZ_TD2;
constexpr size_t WS_B2 = WS_B1 + SZ_TD2;
constexpr size_t WS_LOGF = WS_B2 + SZ_TD2;
constexpr size_t WS_US = WS_LOGF + SZ_TD2;
constexpr size_t WS_MEMN = WS_US + (size_t)4096 * 16384 * 4;
constexpr size_t WS_KP = WS_MEMN + (size_t)1024 * D * 2;
constexpr size_t WS_VT = WS_KP + (size_t)1024 * D * 2;
constexpr size_t WS_DEC = WS_VT + (size_t)1024 * D * 2;
constexpr size_t WS_RSS2 = WS_DEC + (size_t)4096 * 128 * 4;
constexpr size_t WS_RSS3 = WS_RSS2 + (size_t)T * 4;
constexpr size_t WS_LB = WS_RSS3 + (size_t)T * 4;
constexpr size_t WS_WQK = WS_LB + 4096;
constexpr size_t WS_WVO = WS_WQK + (size_t)4 * 1024 * D * 2;
constexpr size_t WS_BAR = WS_WVO + (size_t)4 * D * 1024 * 2;
constexpr size_t WS_END = WS_BAR + 16384;
constexpr size_t WS_WGU = WS_US;
constexpr size_t WS_WDN = WS_US + (size_t)2 * FF * D * 2;
constexpr size_t WS_ACT = WS_B1;
constexpr size_t SZ_HALO = (size_t)512 * 2 * FF * 4;
constexpr size_t WS_GF = WS_H, WS_UF = WS_H + SZ_HALO, WS_GL = WS_H + 2 * SZ_HALO;
static_assert(WS_ACT + (size_t)T * FF * 2 <= WS_US, "act overlaps FFN weights");
static_assert(3 * SZ_HALO <= SZ_TD2, "halo");
static_assert(WS_END <= (size_t)1 << 30, "workspace");

constexpr int STAGE_BYTES = 131072;
constexpr int LDS_BYTES = STAGE_BYTES + 8192 + 16;

struct Params {
    const float* x; const float* mem; const float* hgrn_lb; const float* norm1_w; const float* w_in; const float* hgrn_norm_w; const float* sconv_w;
    const float* w_out; const float* norm2_w; const float* mem_norm_w; const float* wq; const float* wk; const float* wv; const float* wo;
    const float* norm3_w; const float* w_gate; const float* w_up; const float* ffn_conv_w; const float* ffn_conv_b; const float* w_down; const float* final_norm_w;
    float* out; unsigned char* ws; int ph_lo, ph_hi;
};

typedef __bf16 bf16x2_t __attribute__((ext_vector_type(2)));
__device__ __forceinline__ unsigned cvt_pk_bf16_c(float lo, float hi) { const f32x2 v = {lo, hi}; return __builtin_bit_cast(unsigned, __builtin_convertvector(v, bf16x2_t)); }
__device__ __forceinline__ unsigned cvt_pk_bf16(float lo, float hi) { unsigned r; asm volatile("v_cvt_pk_bf16_f32 %0, %1, %2" : "=v"(r) : "v"(lo), "v"(hi)); return r; }
__device__ __forceinline__ float bf_lo(unsigned u) { return __uint_as_float(u << 16); }
__device__ __forceinline__ float bf_hi(unsigned u) { return __uint_as_float(u & 0xffff0000u); }
__device__ __forceinline__ float silu_f(float v) { return v * __builtin_amdgcn_rcpf(1.0f + __expf(-v)); }
__device__ __forceinline__ float wave_sum(float v) {
#pragma unroll
    for (int o = 32; o >= 1; o >>= 1) v += __shfl_xor(v, o);
    return v;
}

namespace pg8 {
constexpr int BM = 256, BK = 64, HALF = 128, HTB = HALF * BK * 2, NXCD = 8, WGM = 8;
__host__ __device__ __forceinline__ int lds_byte(int r, int c) { const int st = (r >> 4) * 2 + (c >> 5), rr = r & 15, cc = c & 31, ob = rr * 64 + cc * 2; return st * 1024 + (ob ^ (((ob >> 9) & 1) << 5)); }
__host__ __device__ __forceinline__ void stage_rc(int b, int& R, int& C) { const int st = b / 1024, sb = b % 1024, swz = sb ^ (((sb >> 9) & 1) << 5); R = (st >> 1) * 16 + swz / 64; C = (st & 1) * 32 + (swz % 64) / 2; }
__host__ __device__ __forceinline__ int perm32(int rho) { const int n = rho >> 4, i = rho & 15; return 8 * (i >> 2) + 4 * n + (i & 3); }

struct Unit { size_t aoff, boff; int pm, pn; };
struct Gemm { const bf16_t* A; const bf16_t* Bt; int lda, ldb, K; };

struct Order {
    int nM, nN, nwg, G, c, mode; size_t lda2, ldb2;
    __device__ void init(int vc, int nM_, int nN_, int mode_, int lda, int ldb, int crot = 0) { nM = nM_; nN = nN_; nwg = nM * nN; G = gridDim.x; c = (int)((unsigned)(vc + crot) % gridDim.x); mode = mode_; lda2 = (size_t)lda * 2; ldb2 = (size_t)ldb * 2; }
    __device__ bool next(int i, Unit& u) const {
        const long L = (long)i * G + c; if (L >= nwg) return false;
        int wgid = (int)L; { const int q = nwg / NXCD, r = nwg % NXCD, xcd = wgid % NXCD, off = wgid / NXCD; wgid = (xcd < r ? xcd * (q + 1) : r * (q + 1) + (xcd - r) * q) + off; }
        const int nig = WGM * nN, gid = wgid / nig, fm = gid * WGM, gsz = (nM - fm) < WGM ? (nM - fm) : WGM;
        const int pm = fm + ((wgid % nig) % gsz), pn = (wgid % nig) / gsz;
        u.pm = pm; u.pn = pn;
        if (mode == 0) { u.aoff = (size_t)pm * 256 * lda2; u.boff = (size_t)pn * 256 * ldb2; }
        else if (mode == 3) { const int b = pm >> 2, h = pm & 3; u.aoff = (size_t)(b * 256) * lda2 + (size_t)h * 1024; u.boff = (size_t)pn * 256 * ldb2 + (size_t)h * 1024; }
        else if (mode == 4) { const int b = pm >> 3, nt_ = pm & 7, h = pn; u.aoff = (size_t)(nt_ * 256) * lda2 + (size_t)h * 1024; u.boff = (size_t)(b * 256) * ldb2 + (size_t)(2048 + h * 512) * 2; }
        else if (mode == 5) { const int b = pm >> 5; u.aoff = (size_t)pm * 256 * lda2; u.boff = (size_t)(b * 1024 + pn * 256) * ldb2; }
        else { const int b = pm >> 5; u.aoff = (size_t)pm * 256 * lda2; u.boff = (size_t)(b * 2048 + pn * 256) * ldb2; }
        return true;
    }
};

template <class Epi>
__device__ __forceinline__ void gemm_phase(LAS unsigned char* lds, const Gemm g, const Order& S, const Epi& E) {
    const int tid = threadIdx.x, wid = __builtin_amdgcn_readfirstlane(tid >> 6), lane = tid & 63, wr = wid >> 2, wc = wid & 3, fr = lane & 15, fq = lane >> 4;
    const int K = g.K, nt = K / BK;
    unsigned voffA[2], voffB[2];
#pragma unroll
    for (int i = 0; i < 2; ++i) { int R, C; stage_rc(tid * 16 + i * 8192, R, C); const int Rb = Epi::PERM ? ((R & ~31) + perm32(R & 31)) : R;
        voffA[i] = (unsigned)(R * g.lda + C) * 2u; voffB[i] = (unsigned)(Rb * g.ldb + C) * 2u; }
    const size_t kstep = (size_t)(BK * 2);
    const size_t hstepA = (size_t)HALF * g.lda * 2, hstepB = (size_t)HALF * g.ldb * 2;
    const unsigned ldsw = (unsigned)wid * 1024u;
    const int aoff = lds_byte(wr * 64 + fr, fq * 8), boff = lds_byte(wc * 32 + fr, fq * 8);
#define PG8_SA(b, h) (((b) * 2 + (h)) * HTB)
#define PG8_SB(b, h) ((4 + (b) * 2 + (h)) * HTB)
#define PG8_STAGE(bufoff, gbase, voff) do { _Pragma("unroll") for (int _i = 0; _i < 2; ++_i) \
        __builtin_amdgcn_global_load_lds((const unsigned*)((const char*)(gbase) + (voff)[_i]), (LAS unsigned*)(lds + (bufoff) + ldsw + _i * 8192), 16, 0, 0); } while (0)
#define PG8_LDA(dst, b, h) do { _Pragma("unroll") for (int m = 0; m < 4; ++m) _Pragma("unroll") for (int k = 0; k < 2; ++k) dst[m][k] = *(const LAS bf16x8*)(lds + PG8_SA(b, h) + aoff + m * 2048 + k * 1024); } while (0)
#define PG8_LDB(dst, b, h) do { _Pragma("unroll") for (int n = 0; n < 2; ++n) _Pragma("unroll") for (int k = 0; k < 2; ++k) dst[n][k] = *(const LAS bf16x8*)(lds + PG8_SB(b, h) + boff + n * 2048 + k * 1024); } while (0)
#define PG8_MMA(ai, bj, At, Bt) do { __builtin_amdgcn_s_setprio(1); _Pragma("unroll") for (int m = 0; m < 4; ++m) _Pragma("unroll") for (int n = 0; n < 2; ++n) _Pragma("unroll") for (int k = 0; k < 2; ++k) \
        acc[ai][bj][m][n] = __builtin_amdgcn_mfma_f32_16x16x32_bf16(Bt[n][k], At[m][k], acc[ai][bj][m][n], 0, 0, 0); __builtin_amdgcn_s_setprio(0); } while (0)
#define PG8_WAIT_V(n) asm volatile("s_waitcnt vmcnt(" #n ")" ::: "memory")
#define PG8_WAIT_L(n) asm volatile("s_waitcnt lgkmcnt(" #n ")" ::: "memory")
#define PG8_BAR __builtin_amdgcn_s_barrier()
#define PG8_SCHED __builtin_amdgcn_sched_barrier(0)
    Unit cur, nxt; int ui = 0;
    if (!S.next(0, cur)) return;
    f32x4 acc[2][2][4][2];
#pragma unroll
    for (int a = 0; a < 2; ++a)
#pragma unroll
        for (int b = 0; b < 2; ++b)
#pragma unroll
            for (int m = 0; m < 4; ++m)
#pragma unroll
                for (int n = 0; n < 2; ++n) acc[a][b][m][n] = (f32x4){0.f, 0.f, 0.f, 0.f};
    bf16x8 At[4][2], B0[2][2], B1[2][2];
    const char* cA = (const char*)g.A + cur.aoff; const char* cB = (const char*)g.Bt + cur.boff;
    PG8_STAGE(PG8_SB(0, 0), cB, voffB); PG8_STAGE(PG8_SB(0, 1), cB + hstepB, voffB); PG8_STAGE(PG8_SA(0, 0), cA, voffA); PG8_STAGE(PG8_SA(0, 1), cA + hstepA, voffA);
    if (wr == 1) PG8_BAR;
    PG8_WAIT_V(2); PG8_BAR;
    PG8_STAGE(PG8_SB(1, 0), cB + kstep, voffB); PG8_STAGE(PG8_SA(1, 0), cA + kstep, voffA); PG8_STAGE(PG8_SB(1, 1), cB + hstepB + kstep, voffB);
    PG8_WAIT_V(6); PG8_BAR;
    for (;;) {
        const bool has_next = S.next(ui + 1, nxt);
        const char* nA = has_next ? (const char*)g.A + nxt.aoff : cA; const char* nB = has_next ? (const char*)g.Bt + nxt.boff : cB;
        for (int t = 0; t < nt; t += 2) {
            const bool last = (t == nt - 2);
            const char* a1 = cA + (size_t)(t + 1) * kstep;
            const char* a2 = last ? nA : cA + (size_t)(t + 2) * kstep; const char* b2 = last ? nB : cB + (size_t)(t + 2) * kstep;
            const char* a3 = a2 + kstep; const char* b3 = b2 + kstep;
            PG8_LDB(B0, 0, 0); PG8_LDB(B1, 0, 1); PG8_SCHED; PG8_LDA(At, 0, 0); PG8_STAGE(PG8_SA(1, 1), a1 + hstepA, voffA);
            PG8_WAIT_V(8); PG8_WAIT_L(0); PG8_BAR; PG8_MMA(0, 0, At, B0); PG8_MMA(0, 1, At, B1); PG8_BAR; PG8_SCHED;
            PG8_LDA(At, 0, 1); PG8_STAGE(PG8_SB(0, 0), b2, voffB); PG8_STAGE(PG8_SB(0, 1), b2 + hstepB, voffB); PG8_STAGE(PG8_SA(0, 0), a2, voffA);
            PG8_WAIT_V(8); PG8_WAIT_L(0); PG8_BAR; PG8_MMA(1, 0, At, B0); PG8_MMA(1, 1, At, B1); PG8_BAR; PG8_SCHED;
            PG8_LDB(B0, 1, 0); PG8_LDB(B1, 1, 1); PG8_SCHED; PG8_LDA(At, 1, 0); PG8_STAGE(PG8_SA(0, 1), a2 + hstepA, voffA);
            PG8_WAIT_V(8); PG8_WAIT_L(0); PG8_BAR; PG8_MMA(0, 0, At, B0); PG8_MMA(0, 1, At, B1); PG8_BAR; PG8_SCHED;
            PG8_LDA(At, 1, 1); PG8_STAGE(PG8_SB(1, 0), b3, voffB); PG8_STAGE(PG8_SB(1, 1), b3 + hstepB, voffB); PG8_STAGE(PG8_SA(1, 0), a3, voffA);
            PG8_WAIT_V(8); PG8_WAIT_L(0); PG8_BAR; PG8_MMA(1, 0, At, B0); PG8_MMA(1, 1, At, B1); PG8_BAR; PG8_SCHED;
        }
        if (wr == 0) PG8_BAR;
        E(acc, cur, wr, wc, fr, fq);
        if (!has_next) break;
#pragma unroll
        for (int a = 0; a < 2; ++a)
#pragma unroll
            for (int b = 0; b < 2; ++b)
#pragma unroll
                for (int m = 0; m < 4; ++m)
#pragma unroll
                    for (int n = 0; n < 2; ++n) acc[a][b][m][n] = (f32x4){0.f, 0.f, 0.f, 0.f};
        cur = nxt; cA = nA; cB = nB; ++ui;
        if (wr == 1) PG8_BAR;
    }
    PG8_WAIT_V(0);
    PG8_BAR;
#undef PG8_SA
#undef PG8_SB
#undef PG8_STAGE
#undef PG8_LDA
#undef PG8_LDB
#undef PG8_MMA
#undef PG8_WAIT_V
#undef PG8_WAIT_L
#undef PG8_BAR
#undef PG8_SCHED
}

typedef f32x4 Acc[2][2][4][2];

struct EpiIn {
    static constexpr bool PERM = true;
    bf16_t* proj; float* logf; const float* lb;
    __device__ __forceinline__ void operator()(Acc& acc, const Unit& u, int wr, int wc, int fr, int fq) const {
        const int row0 = u.pm * 256 + wr * 64 + fr, sec = u.pn >> 2, colt = u.pn * 256 + wc * 32 + 8 * fq;
        if (sec == 1) {
#pragma unroll
            for (int bj = 0; bj < 2; ++bj) {
                const int c = colt + bj * 128 - 1024;
                const f32x4 l0 = *(const f32x4*)(lb + c), l1 = *(const f32x4*)(lb + c + 4);
#pragma unroll
                for (int ai = 0; ai < 2; ++ai)
#pragma unroll
                    for (int m = 0; m < 4; ++m) {
                        const size_t row = (size_t)(row0 + ai * 128 + m * 16);
                        f32x4 o0, o1;
#pragma unroll
                        for (int j = 0; j < 4; ++j) {
                            const float s0 = __builtin_amdgcn_rcpf(1.0f + __expf(-acc[ai][bj][m][0][j])), s1 = __builtin_amdgcn_rcpf(1.0f + __expf(-acc[ai][bj][m][1][j]));
                            o0[j] = __logf(l0[j] + (1.0f - l0[j]) * s0); o1[j] = __logf(l1[j] + (1.0f - l1[j]) * s1);
                        }
                        float* dst = logf + row * 1024 + c;
                        *(f32x4*)dst = o0; *(f32x4*)(dst + 4) = o1;
                    }
            }
        } else {
            const int cb = (sec == 0) ? colt : colt - 1024;
#pragma unroll
            for (int ai = 0; ai < 2; ++ai)
#pragma unroll
                for (int m = 0; m < 4; ++m) {
                    bf16_t* rowp = proj + (size_t)(row0 + ai * 128 + m * 16) * PJ + cb;
#pragma unroll
                    for (int bj = 0; bj < 2; ++bj) {
                        f32x4 v0 = acc[ai][bj][m][0], v1 = acc[ai][bj][m][1];
                        if (sec == 0) {
#pragma unroll
                            for (int j = 0; j < 4; ++j) { v0[j] = silu_f(v0[j]); v1[j] = silu_f(v1[j]); }
                        }
                        u32x4 w; w.x = cvt_pk_bf16(v0[0], v0[1]); w.y = cvt_pk_bf16(v0[2], v0[3]); w.z = cvt_pk_bf16(v1[0], v1[1]); w.w = cvt_pk_bf16(v1[2], v1[3]);
                        *(u32x4*)(rowp + bj * 128) = w;
                    }
                }
        }
    }
};

struct EpiB {
    static constexpr bool PERM = true;
    bf16_t* O; int ldc; const float* rss;
    __device__ __forceinline__ void operator()(Acc& acc, const Unit& u, int wr, int wc, int fr, int fq) const {
        const int row0 = u.pm * 256 + wr * 64 + fr, col0 = u.pn * 256 + wc * 32 + 8 * fq;
#pragma unroll
        for (int ai = 0; ai < 2; ++ai)
#pragma unroll
            for (int m = 0; m < 4; ++m) {
                const int row = row0 + ai * 128 + m * 16;
                const float s = rss ? rsqrtf(rss[row] * (1.0f / D) + EPS) : 1.0f;
                bf16_t* rowp = O + (size_t)row * ldc + col0;
#pragma unroll
                for (int bj = 0; bj < 2; ++bj) {
                    const f32x4 v0 = acc[ai][bj][m][0] * s, v1 = acc[ai][bj][m][1] * s;
                    u32x4 w; w.x = cvt_pk_bf16(v0[0], v0[1]); w.y = cvt_pk_bf16(v0[2], v0[3]); w.z = cvt_pk_bf16(v1[0], v1[1]); w.w = cvt_pk_bf16(v1[2], v1[3]);
                    *(u32x4*)(rowp + bj * 128) = w;
                }
            }
    }
};

template <bool XIN_BF16, bool OUT_F32, bool OUT_B, bool RSS> struct EpiRes {
    static constexpr bool PERM = true;
    const void* xin; float* xout; bf16_t* xb; float* rss;
    __device__ __forceinline__ void operator()(Acc& acc, const Unit& u, int wr, int wc, int fr, int fq) const {
        const int row0 = u.pm * 256 + wr * 64 + fr, col0 = u.pn * 256 + wc * 32 + 8 * fq;
#pragma unroll
        for (int ai = 0; ai < 2; ++ai) {
            f32x4 xi[4][2][2];
#pragma unroll
            for (int m = 0; m < 4; ++m)
#pragma unroll
                for (int bj = 0; bj < 2; ++bj) {
                    const size_t o = (size_t)(row0 + ai * 128 + m * 16) * D + col0 + bj * 128;
                    if (XIN_BF16) { const u32x4 r = *(const u32x4*)((const bf16_t*)xin + o);
                        xi[m][bj][0] = (f32x4){bf_lo(r.x), bf_hi(r.x), bf_lo(r.y), bf_hi(r.y)}; xi[m][bj][1] = (f32x4){bf_lo(r.z), bf_hi(r.z), bf_lo(r.w), bf_hi(r.w)}; }
                    else { xi[m][bj][0] = *(const f32x4*)((const float*)xin + o); xi[m][bj][1] = *(const f32x4*)((const float*)xin + o + 4); }
                }
#pragma unroll
            for (int m = 0; m < 4; ++m) {
                const size_t row = (size_t)(row0 + ai * 128 + m * 16);
                float ss = 0.f;
#pragma unroll
                for (int bj = 0; bj < 2; ++bj) {
                    const size_t o = row * D + col0 + bj * 128;
                    const f32x4 v0 = acc[ai][bj][m][0] + xi[m][bj][0], v1 = acc[ai][bj][m][1] + xi[m][bj][1];
                    if (OUT_F32) { *(f32x4*)(xout + o) = v0; *(f32x4*)(xout + o + 4) = v1; }
                    if (OUT_B) {
                        u32x4 w; w.x = cvt_pk_bf16(v0[0], v0[1]); w.y = cvt_pk_bf16(v0[2], v0[3]); w.z = cvt_pk_bf16(v1[0], v1[1]); w.w = cvt_pk_bf16(v1[2], v1[3]);
                        *(u32x4*)(xb + o) = w;
                        if (RSS) {
#pragma unroll
                            for (int j = 0; j < 4; ++j) ss += v0[j] * v0[j] + v1[j] * v1[j];
                        }
                    }
                }
                if (RSS) { ss += __shfl_xor(ss, 16); ss += __shfl_xor(ss, 32); if (fq == 0) atomicAdd(rss + row, ss); }
            }
        }
    }
};

struct EpiSm {
    static constexpr bool PERM = true;
    bf16_t* P; LAS float* xl; const float* rss;
    __device__ __forceinline__ void operator()(Acc& acc, const Unit& u, int wr, int wc, int fr, int fq) const {
        const float sc0 = 0.044194173824159216f * 1.4426950408889634f;
        const int rl0 = wr * 64 + fr;
        const int rowg0 = u.pm * 256 + wr * 64 + fr;
#pragma unroll
        for (int ai = 0; ai < 2; ++ai)
#pragma unroll
            for (int m = 0; m < 4; ++m) {
                float mx = -3.0e38f;
#pragma unroll
                for (int bj = 0; bj < 2; ++bj)
#pragma unroll
                    for (int n = 0; n < 2; ++n)
#pragma unroll
                        for (int j = 0; j < 4; ++j) mx = fmaxf(mx, acc[ai][bj][m][n][j]);
                mx = fmaxf(mx, __shfl_xor(mx, 16)); mx = fmaxf(mx, __shfl_xor(mx, 32));
                if (fq == 0) xl[(rl0 + ai * 128 + m * 16) * 4 + wc] = mx;
            }
        asm volatile("s_waitcnt lgkmcnt(0)" ::: "memory"); __builtin_amdgcn_s_barrier(); asm volatile("" ::: "memory");
#pragma unroll
        for (int ai = 0; ai < 2; ++ai)
#pragma unroll
            for (int m = 0; m < 4; ++m) {
                const int rl = rl0 + ai * 128 + m * 16;
                const f32x4 mm = *(const LAS f32x4*)(xl + rl * 4);
                const float sc = sc0 * rsqrtf(rss[rowg0 + ai * 128 + m * 16] * (1.0f / D) + EPS);
                const float M = fmaxf(fmaxf(mm[0], mm[1]), fmaxf(mm[2], mm[3])) * sc;
                float sum = 0.f;
#pragma unroll
                for (int bj = 0; bj < 2; ++bj)
#pragma unroll
                    for (int n = 0; n < 2; ++n)
#pragma unroll
                        for (int j = 0; j < 4; ++j) { const float pv = exp2f(acc[ai][bj][m][n][j] * sc - M); acc[ai][bj][m][n][j] = pv; sum += pv; }
                sum += __shfl_xor(sum, 16); sum += __shfl_xor(sum, 32);
                if (fq == 0) xl[1024 + rl * 4 + wc] = sum;
            }
        asm volatile("s_waitcnt lgkmcnt(0)" ::: "memory"); __builtin_amdgcn_s_barrier(); asm volatile("" ::: "memory");
        const int row0 = u.pm * 256 + wr * 64 + fr, col0 = u.pn * 256 + wc * 32 + 8 * fq;
#pragma unroll
        for (int ai = 0; ai < 2; ++ai)
#pragma unroll
            for (int m = 0; m < 4; ++m) {
                const int rl = rl0 + ai * 128 + m * 16;
                const f32x4 ss = *(const LAS f32x4*)(xl + 1024 + rl * 4);
                const float inv = 1.0f / (ss[0] + ss[1] + ss[2] + ss[3]);
                bf16_t* rowp = P + (size_t)(row0 + ai * 128 + m * 16) * 1024 + col0;
#pragma unroll
                for (int bj = 0; bj < 2; ++bj) {
                    const f32x4 v0 = acc[ai][bj][m][0] * inv, v1 = acc[ai][bj][m][1] * inv;
                    u32x4 w; w.x = cvt_pk_bf16(v0[0], v0[1]); w.y = cvt_pk_bf16(v0[2], v0[3]); w.z = cvt_pk_bf16(v1[0], v1[1]); w.w = cvt_pk_bf16(v1[2], v1[3]);
                    *(u32x4*)(rowp + bj * 128) = w;
                }
            }
    }
};

struct EpiGu {
    static constexpr bool PERM = true;
    bf16_t* act; const float* rss; const float* cw; const float* cbias; float* gf; float* uf; float* gl;
    __device__ __forceinline__ void operator()(Acc& acc, const Unit& u, int wr, int wc, int fr, int fq) const {
        const int row0 = u.pm * 256 + wr * 64 + fr, c0 = u.pn * 128 + wc * 32 + 8 * fq;
#pragma unroll
        for (int ai = 0; ai < 2; ++ai) {
            float rs[4];
#pragma unroll
            for (int m = 0; m < 4; ++m) rs[m] = rsqrtf(rss[row0 + ai * 128 + m * 16] * (1.0f / D) + EPS);
            const int blk = u.pm * 4 + ai * 2 + wr;
            unsigned pk[4][4];
#pragma unroll
            for (int n = 0; n < 2; ++n) {
                const f32x4 w0 = *(const f32x4*)(cw + c0 + 4 * n), w1 = *(const f32x4*)(cw + FF + c0 + 4 * n), w2 = *(const f32x4*)(cw + 2 * FF + c0 + 4 * n), bb = *(const f32x4*)(cbias + c0 + 4 * n);
#pragma unroll
                for (int jp = 0; jp < 2; ++jp) {
                    const f32x2 w0p = {w0[2 * jp], w0[2 * jp + 1]}, w1p = {w1[2 * jp], w1[2 * jp + 1]}, w2p = {w2[2 * jp], w2[2 * jp + 1]}, bbp = {bb[2 * jp], bb[2 * jp + 1]};
                    f32x2 gm[4], r1[4], r2[4];
#pragma unroll
                    for (int m = 0; m < 4; ++m) {
                        gm[m] = (f32x2){acc[ai][0][m][n][2 * jp], acc[ai][0][m][n][2 * jp + 1]} * rs[m];
                        r1[m].x = __int_as_float(__builtin_amdgcn_update_dpp(0, __float_as_int(gm[m].x), 0x121, 0xF, 0xF, false));
                        r1[m].y = __int_as_float(__builtin_amdgcn_update_dpp(0, __float_as_int(gm[m].y), 0x121, 0xF, 0xF, false));
                        r2[m].x = __int_as_float(__builtin_amdgcn_update_dpp(0, __float_as_int(gm[m].x), 0x122, 0xF, 0xF, false));
                        r2[m].y = __int_as_float(__builtin_amdgcn_update_dpp(0, __float_as_int(gm[m].y), 0x122, 0xF, 0xF, false));
                    }
#pragma unroll
                    for (int m = 0; m < 4; ++m) {
                        const f32x2 q1 = m >= 1 ? r1[m >= 1 ? m - 1 : 0] : (f32x2){0.f, 0.f}, q2 = m >= 1 ? r2[m >= 1 ? m - 1 : 0] : (f32x2){0.f, 0.f};
                        f32x2 p1, p2;
                        p1.x = (fr >= 1) ? r1[m].x : q1.x; p1.y = (fr >= 1) ? r1[m].y : q1.y;
                        p2.x = (fr >= 2) ? r2[m].x : q2.x; p2.y = (fr >= 2) ? r2[m].y : q2.y;
                        const f32x2 a = w2p * gm[m] + (w1p * p1 + (w0p * p2 + bbp));
                        const f32x2 na = a * (-1.4426950408889634f);
                        f32x2 den; den.x = __builtin_amdgcn_exp2f(na.x); den.y = __builtin_amdgcn_exp2f(na.y);
                        den = den + 1.0f;
                        f32x2 rc; rc.x = __builtin_amdgcn_rcpf(den.x); rc.y = __builtin_amdgcn_rcpf(den.y);
                        const f32x2 up = (f32x2){acc[ai][1][m][n][2 * jp], acc[ai][1][m][n][2 * jp + 1]} * rs[m];
                        const f32x2 ov = (a * rc) * up;
                        pk[m][2 * n + jp] = cvt_pk_bf16(ov.x, ov.y);
                    }
                }
            }
#pragma unroll
            for (int m = 0; m < 4; ++m) {
                const size_t row = (size_t)(row0 + ai * 128 + m * 16);
                if (!(m == 0 && fr < 2)) { u32x4 w; w.x = pk[m][0]; w.y = pk[m][1]; w.z = pk[m][2]; w.w = pk[m][3]; *(u32x4*)(act + row * FF + c0) = w; }
            }
            if (fr < 2) {
                const size_t o = ((size_t)blk * 2 + fr) * FF + c0;
                *(f32x4*)(gf + o) = acc[ai][0][0][0] * rs[0]; *(f32x4*)(gf + o + 4) = acc[ai][0][0][1] * rs[0];
                *(f32x4*)(uf + o) = acc[ai][1][0][0] * rs[0]; *(f32x4*)(uf + o + 4) = acc[ai][1][0][1] * rs[0];
            }
            if (fr >= 14) {
                const size_t o = ((size_t)blk * 2 + (fr - 14)) * FF + c0;
                *(f32x4*)(gl + o) = acc[ai][0][3][0] * rs[3]; *(f32x4*)(gl + o + 4) = acc[ai][0][3][1] * rs[3];
            }
        }
    }
};
}

__device__ __forceinline__ void transpose_tile(const float* __restrict__ src, int K, int N, bf16_t* __restrict__ dst, const float* __restrict__ scale, int k0, int n0, int rowmode, LAS float* tl) {
    const int tid = threadIdx.x;
    const int r = tid >> 6, c4 = (tid & 63) * 4;
    f32x4 v[8];
#pragma unroll
    for (int i = 0; i < 8; ++i) v[i] = *(const f32x4*)(src + (size_t)(k0 + r + 8 * i) * N + n0 + c4);
#pragma unroll
    for (int i = 0; i < 8; ++i) {
        const int k = r + 8 * i;
        const float s = scale ? scale[k0 + k] : 1.0f;
        tl[k * 257 + c4 + 0] = v[i][0] * s; tl[k * 257 + c4 + 1] = v[i][1] * s; tl[k * 257 + c4 + 2] = v[i][2] * s; tl[k * 257 + c4 + 3] = v[i][3] * s;
    }
    __syncthreads();
    const int kg = (tid & 7) * 8;
#pragma unroll
    for (int q = 0; q < 4; ++q) {
        const int n = (tid >> 3) + 64 * q;
        float f[8];
#pragma unroll
        for (int j = 0; j < 8; ++j) f[j] = tl[(kg + j) * 257 + n];
        const int c = n0 + n;
        const int drow = rowmode == 0 ? c : (256 * (c >> 7) + (c & 127) + (rowmode == 2 ? 128 : 0));
        u32x4 w; w.x = cvt_pk_bf16(f[0], f[1]); w.y = cvt_pk_bf16(f[2], f[3]); w.z = cvt_pk_bf16(f[4], f[5]); w.w = cvt_pk_bf16(f[6], f[7]);
        *(u32x4*)(dst + (size_t)drow * K + k0 + kg) = w;
    }
    __syncthreads();
}

__device__ __forceinline__ void convert_tile(const float* __restrict__ src, int N, bf16_t* __restrict__ dst, const float* __restrict__ scale, int k0, int n0) {
    const int tid = threadIdx.x, r = tid >> 6, c4 = (tid & 63) * 4;
    f32x4 v[8];
#pragma unroll
    for (int i = 0; i < 8; ++i) v[i] = *(const f32x4*)(src + (size_t)(k0 + r + 8 * i) * N + n0 + c4);
#pragma unroll
    for (int i = 0; i < 8; ++i) {
        const int k = k0 + r + 8 * i;
        const float sc = scale[k];
        u32x2 o; o.x = cvt_pk_bf16(v[i][0] * sc, v[i][1] * sc); o.y = cvt_pk_bf16(v[i][2] * sc, v[i][3] * sc);
        *(u32x2*)(dst + (size_t)k * N + n0 + c4) = o;
    }
}

__device__ __forceinline__ void rmsnorm_row_bf16(const float* __restrict__ src, const float* __restrict__ w, bf16_t* __restrict__ dst, int lane) {
    f32x4 v[8]; float ss = 0.f;
#pragma unroll
    for (int i = 0; i < 8; ++i) { v[i] = *(const f32x4*)(src + i * 256 + lane * 4); ss += v[i][0] * v[i][0] + v[i][1] * v[i][1] + v[i][2] * v[i][2] + v[i][3] * v[i][3]; }
    ss = wave_sum(ss);
    const float rstd = rsqrtf(ss * (1.0f / D) + EPS);
#pragma unroll
    for (int i = 0; i < 8; ++i) {
        const f32x4 g = *(const f32x4*)(w + i * 256 + lane * 4);
        u32x2 o; o.x = cvt_pk_bf16(v[i][0] * rstd * g[0], v[i][1] * rstd * g[1]); o.y = cvt_pk_bf16(v[i][2] * rstd * g[2], v[i][3] * rstd * g[3]);
        *(u32x2*)(dst + i * 256 + lane * 4) = o;
    }
}

__device__ void phase_prep(const Params& p, LAS unsigned char* lds) {
    const int tid = threadIdx.x, lane = tid & 63, w = tid >> 6;
    unsigned char* ws = p.ws;
    for (int t = blockIdx.x; t < 896 + 5 * 256; t += gridDim.x) {
        if (t < 896) { const int tk = t / 28, tn = t % 28; transpose_tile(p.w_in, D, INC, (bf16_t*)(ws + WS_WIN), nullptr, tk * 64, tn * 256, 0, (LAS float*)lds); }
        else { const int q = (t - 896) >> 8, r = (t - 896) & 255, tk = r >> 3, tn = r & 7;
            const float* src = q == 0 ? p.w_out : q == 1 ? p.wq : q == 2 ? p.wk : q == 3 ? p.wv : p.wo;
            const size_t off = q == 0 ? WS_WOUT : q == 1 ? WS_WQ : q == 2 ? WS_WK : q == 3 ? WS_WV : WS_WO;
            if (q == 1) convert_tile(src, D, (bf16_t*)(ws + off), p.norm2_w, tk * 64, tn * 256);
            else transpose_tile(src, D, D, (bf16_t*)(ws + off), nullptr, tk * 64, tn * 256, 0, (LAS float*)lds); }
    }
    for (int r = blockIdx.x * 8 + w; r < T + 1024; r += gridDim.x * 8) {
        if (r < T) rmsnorm_row_bf16(p.x + (size_t)r * D, p.norm1_w, (bf16_t*)(ws + WS_H) + (size_t)r * D, lane);
        else rmsnorm_row_bf16(p.mem + (size_t)(r - T) * D, p.mem_norm_w, (bf16_t*)(ws + WS_MEMN) + (size_t)(r - T) * D, lane);
    }
    for (int i = blockIdx.x * 512 + tid; i < 2 * T; i += gridDim.x * 512) ((float*)(ws + WS_RSS2))[i] = 0.f;
    for (int i = blockIdx.x * 512 + tid; i < 1024; i += gridDim.x * 512) { const float a0 = p.hgrn_lb[i], a1 = p.hgrn_lb[1024 + i]; ((float*)(ws + WS_LB))[i] = 1.0f / (1.0f + __expf(a1 - a0)); }
}

__device__ void phase_ffn_weights(const Params& p, LAS unsigned char* lds) {
    unsigned char* ws = p.ws;
    for (int t = blockIdx.x; t < 3 * 704; t += gridDim.x) {
        const int q = t / 704, r = t % 704;
        if (q < 2) { const int tk = r / 22, tn = r % 22; transpose_tile(q == 0 ? p.w_gate : p.w_up, D, FF, (bf16_t*)(ws + WS_WGU), p.norm3_w, tk * 64, tn * 256, 1 + q, (LAS float*)lds); }
        else { const int tk = r >> 3, tn = r & 7; transpose_tile(p.w_down, FF, D, (bf16_t*)(ws + WS_WDN), nullptr, tk * 64, tn * 256, 0, (LAS float*)lds); }
    }
}

#define LDS_BARRIER() do { asm volatile("s_waitcnt lgkmcnt(0)" ::: "memory"); __builtin_amdgcn_s_barrier(); asm volatile("" ::: "memory"); } while (0)
__device__ __forceinline__ int hgrn_item_of(int slot, bool deal, int c) {
    if (!deal) { const int item = blockIdx.x + slot * gridDim.x; return item < 4096 ? item : -1; }
    if (c < 64) return slot < 3 ? c + 256 * slot : -1;
    if (slot < 16) return c + 256 * slot;
    if (slot >= 21) return -1;
    const int r = (slot - 16) * 192 + (c - 64);
    return r < 832 ? (3 + (r >> 6)) * 256 + (r & 63) : -1;
}

__device__ void phase_hgrn_local(const Params& p, LAS unsigned char* lds, int vc) {
    const int tid = threadIdx.x, lane = tid & 63, w = tid >> 6, fr = lane & 15, fq = lane >> 4;
    LAS bf16_t* Ak = (LAS bf16_t*)(lds);
    LAS bf16_t* Vt = (LAS bf16_t*)(lds + 18432);
    LAS float* tots = (LAS float*)(lds + 36864);
    const float* logf = (const float*)(p.ws + WS_LOGF);
    const bf16_t* proj = (const bf16_t*)(p.ws + WS_B0);
    bf16_t* us = (bf16_t*)(p.ws + WS_US);
    float* dec = (float*)(p.ws + WS_DEC);
    const bool deal = (gridDim.x == 256);
    const int kp = lane, sg = w;
    f32x2 c[8]; unsigned vv[8];
#define HL_LOAD(ITEM) do { const int _it = (ITEM); const int _bh = _it >> 7, _n = _it & 127, _b = _bh >> 3, _h = _bh & 7; const size_t _t0 = (size_t)_b * SEQ + (size_t)_n * 64; \
        _Pragma("unroll") for (int i = 0; i < 8; ++i) { c[i] = *(const f32x2*)(logf + (_t0 + 8 * sg + i) * 1024 + _h * 128 + 2 * kp); vv[i] = *(const unsigned*)(proj + (_t0 + 8 * sg + i) * PJ + 1024 + _h * 128 + 2 * kp); } } while (0)
    int item = hgrn_item_of(0, deal, vc);
    if (item >= 0) HL_LOAD(item);
    for (int slot = 0; item >= 0; ++slot) {
        const int nitem = hgrn_item_of(slot + 1, deal, vc);
        f32x2 kk[8];
#pragma unroll
        for (int i = 0; i < 8; ++i) { kk[i].x = 1.0f - __expf(c[i].x); kk[i].y = 1.0f - __expf(c[i].y); }
#pragma unroll
        for (int i = 1; i < 8; ++i) c[i] += c[i - 1];
        *(LAS f32x2*)(tots + sg * 128 + 2 * kp) = c[7];
        LDS_BARRIER();
        f32x2 off = {0.f, 0.f}, tot = {0.f, 0.f};
#pragma unroll
        for (int g = 0; g < 8; ++g) { const f32x2 tv = *(const LAS f32x2*)(tots + g * 128 + 2 * kp); if (g < sg) off += tv; tot += tv; }
        float e0[8], e1[8];
#pragma unroll
        for (int i = 0; i < 8; ++i) { e0[i] = kk[i].x * __expf(tot.x - off.x - c[i].x); e1[i] = kk[i].y * __expf(tot.y - off.y - c[i].y); }
        u32x4 a0, a1, v0, v1;
        a0.x = cvt_pk_bf16(e0[0], e0[1]); a0.y = cvt_pk_bf16(e0[2], e0[3]); a0.z = cvt_pk_bf16(e0[4], e0[5]); a0.w = cvt_pk_bf16(e0[6], e0[7]);
        a1.x = cvt_pk_bf16(e1[0], e1[1]); a1.y = cvt_pk_bf16(e1[2], e1[3]); a1.z = cvt_pk_bf16(e1[4], e1[5]); a1.w = cvt_pk_bf16(e1[6], e1[7]);
        v0.x = (vv[0] & 0xffffu) | (vv[1] << 16); v0.y = (vv[2] & 0xffffu) | (vv[3] << 16); v0.z = (vv[4] & 0xffffu) | (vv[5] << 16); v0.w = (vv[6] & 0xffffu) | (vv[7] << 16);
        v1.x = (vv[0] >> 16) | (vv[1] & 0xffff0000u); v1.y = (vv[2] >> 16) | (vv[3] & 0xffff0000u); v1.z = (vv[4] >> 16) | (vv[5] & 0xffff0000u); v1.w = (vv[6] >> 16) | (vv[7] & 0xffff0000u);
        *(LAS u32x4*)(Ak + (2 * kp) * 72 + 8 * sg) = a0; *(LAS u32x4*)(Ak + (2 * kp + 1) * 72 + 8 * sg) = a1;
        *(LAS u32x4*)(Vt + (2 * kp) * 72 + 8 * sg) = v0; *(LAS u32x4*)(Vt + (2 * kp + 1) * 72 + 8 * sg) = v1;
        if (sg == 0) { f32x2 d; d.x = __expf(tot.x); d.y = __expf(tot.y); *(f32x2*)(dec + (size_t)item * 128 + 2 * kp) = d; }
        if (nitem >= 0) HL_LOAD(nitem);
        LDS_BARRIER();
        f32x4 acc[8];
#pragma unroll
        for (int kt = 0; kt < 8; ++kt) acc[kt] = (f32x4){0.f, 0.f, 0.f, 0.f};
#pragma unroll
        for (int ks = 0; ks < 2; ++ks) {
            const bf16x8 bq = *(const LAS bf16x8*)(Vt + (16 * w + fr) * 72 + 32 * ks + 8 * fq);
#pragma unroll
            for (int kt = 0; kt < 8; ++kt) { const bf16x8 a = *(const LAS bf16x8*)(Ak + (16 * kt + fr) * 72 + 32 * ks + 8 * fq); acc[kt] = __builtin_amdgcn_mfma_f32_16x16x32_bf16(a, bq, acc[kt], 0, 0, 0); }
        }
        bf16_t* dst = us + (size_t)item * 16384 + (16 * w + fr) * 128 + 4 * fq;
#pragma unroll
        for (int kt = 0; kt < 8; ++kt) { u32x2 o; o.x = cvt_pk_bf16_c(acc[kt][0], acc[kt][1]); o.y = cvt_pk_bf16_c(acc[kt][2], acc[kt][3]); *(u32x2*)(dst + 16 * kt) = o; }
        LDS_BARRIER();
        item = nitem;
    }
#undef HL_LOAD
}

__device__ void phase_hgrn_scan(const Params& p) {
    const bf16_t* us = (const bf16_t*)(p.ws + WS_US);
    bf16_t* sb = (bf16_t*)p.out;
    const float* dec = (const float*)(p.ws + WS_DEC);
    for (int idx = blockIdx.x * 512 + threadIdx.x; idx < 32 * 4096; idx += gridDim.x * 512) {
        const int bh = idx >> 12, e = (idx & 4095) * 4, k = e & 127;
        const bf16_t* base = us + (size_t)bh * 128 * 16384 + e;
        bf16_t* obase = sb + (size_t)bh * 128 * 16384 + e;
        const float* dbase = dec + (size_t)bh * 128 * 128 + k;
        f32x4 s = {0.f, 0.f, 0.f, 0.f};
        for (int n0 = 0; n0 < 128; n0 += 8) {
            u32x2 uu[8]; f32x4 dd[8];
#pragma unroll
            for (int i = 0; i < 8; ++i) { uu[i] = *(const u32x2*)(base + (size_t)(n0 + i) * 16384); dd[i] = *(const f32x4*)(dbase + (n0 + i) * 128); }
#pragma unroll
            for (int i = 0; i < 8; ++i) {
                u32x2 o; o.x = cvt_pk_bf16(s[0], s[1]); o.y = cvt_pk_bf16(s[2], s[3]);
                *(u32x2*)(obase + (size_t)(n0 + i) * 16384) = o;
                const f32x4 u4 = {bf_lo(uu[i].x), bf_hi(uu[i].x), bf_lo(uu[i].y), bf_hi(uu[i].y)};
                s = s * dd[i] + u4;
            }
        }
    }
}

__device__ void phase_hgrn_out(const Params& p, LAS unsigned char* lds) {
    const int tid = threadIdx.x, lane = tid & 63, w = tid >> 6, fr = lane & 15, fq = lane >> 4;
    LAS bf16_t* Qe = (LAS bf16_t*)(lds);
    LAS bf16_t* Ke = (LAS bf16_t*)(lds + 17408);
    LAS bf16_t* St = (LAS bf16_t*)(lds + 34816);
    LAS bf16_t* Vt = (LAS bf16_t*)(lds + 69632);
    LAS bf16_t* Pm = (LAS bf16_t*)(lds + 88064);
    LAS float* tots = (LAS float*)(lds + 97280);
    LAS float* ssq = (LAS float*)(lds + 101376);
    const float* logf = (const float*)(p.ws + WS_LOGF);
    const bf16_t* proj = (const bf16_t*)(p.ws + WS_B0);
    const bf16_t* us = (const bf16_t*)p.out;
    bf16_t* mix = (bf16_t*)(p.ws + WS_H);
    const int kp = lane, sg = w;
    f32x2 c[8]; unsigned vv[8], qv[8]; u32x2 sv[8];
#define HG_LOAD_PRE(ITEM) do { const int _it = (ITEM); const int _bh = _it >> 7, _n = _it & 127, _b = _bh >> 3, _h = _bh & 7; const size_t _t0 = (size_t)_b * SEQ + (size_t)_n * 64; \
        _Pragma("unroll") for (int i = 0; i < 8; ++i) { const size_t t = _t0 + 8 * sg + i; \
            c[i] = *(const f32x2*)(logf + t * 1024 + _h * 128 + 2 * kp); qv[i] = *(const unsigned*)(proj + t * PJ + _h * 128 + 2 * kp); vv[i] = *(const unsigned*)(proj + t * PJ + 1024 + _h * 128 + 2 * kp); } \
        _Pragma("unroll") for (int i = 0; i < 8; ++i) { const int idx = tid + 512 * i; sv[i] = *(const u32x2*)(us + (size_t)_it * 16384 + (idx >> 5) * 128 + (idx & 31) * 4); } } while (0)
    if ((int)blockIdx.x < 4096) HG_LOAD_PRE(blockIdx.x);
    for (int item = blockIdx.x; item < 4096; item += gridDim.x) {
        const int bh = item >> 7, n = item & 127, b = bh >> 3, h = bh & 7;
        const size_t t0 = (size_t)b * SEQ + (size_t)n * 64;
        f32x2 kk[8];
#pragma unroll
        for (int i = 0; i < 8; ++i) { kk[i].x = 1.0f - __expf(c[i].x); kk[i].y = 1.0f - __expf(c[i].y); }
#pragma unroll
        for (int i = 1; i < 8; ++i) c[i] += c[i - 1];
        *(LAS f32x2*)(tots + sg * 128 + 2 * kp) = c[7];
        LDS_BARRIER();
        f32x2 off = {0.f, 0.f}, tot = {0.f, 0.f};
#pragma unroll
        for (int g = 0; g < 8; ++g) { const f32x2 tv = *(const LAS f32x2*)(tots + g * 128 + 2 * kp); if (g < sg) off += tv; tot += tv; }
        const f32x2 ref = tot * 0.5f;
#pragma unroll
        for (int i = 0; i < 8; ++i) {
            const float bx = off.x + c[i].x - ref.x, by = off.y + c[i].y - ref.y;
            const int t = 8 * sg + i;
            *(LAS unsigned*)(Qe + t * 136 + 2 * kp) = cvt_pk_bf16(bf_lo(qv[i]) * __expf(bx), bf_hi(qv[i]) * __expf(by));
            *(LAS unsigned*)(Ke + t * 136 + 2 * kp) = cvt_pk_bf16(kk[i].x * __expf(-bx), kk[i].y * __expf(-by));
        }
        {
            u32x4 v0, v1;
            v0.x = (vv[0] & 0xffffu) | (vv[1] << 16); v0.y = (vv[2] & 0xffffu) | (vv[3] << 16); v0.z = (vv[4] & 0xffffu) | (vv[5] << 16); v0.w = (vv[6] & 0xffffu) | (vv[7] << 16);
            v1.x = (vv[0] >> 16) | (vv[1] & 0xffff0000u); v1.y = (vv[2] >> 16) | (vv[3] & 0xffff0000u); v1.z = (vv[4] >> 16) | (vv[5] & 0xffff0000u); v1.w = (vv[6] >> 16) | (vv[7] & 0xffff0000u);
            *(LAS u32x4*)(Vt + (2 * kp) * 72 + 8 * sg) = v0; *(LAS u32x4*)(Vt + (2 * kp + 1) * 72 + 8 * sg) = v1;
        }
        {
            const int k4 = (tid & 31) * 4;
            f32x4 tt = {0.f, 0.f, 0.f, 0.f};
#pragma unroll
            for (int g = 0; g < 8; ++g) tt += *(const LAS f32x4*)(tots + g * 128 + k4);
            const f32x4 er = {__expf(0.5f * tt[0]), __expf(0.5f * tt[1]), __expf(0.5f * tt[2]), __expf(0.5f * tt[3])};
#pragma unroll
            for (int i = 0; i < 8; ++i) {
                const int v = (tid >> 5) + 16 * i;
                u32x2 o; o.x = cvt_pk_bf16(bf_lo(sv[i].x) * er[0], bf_hi(sv[i].x) * er[1]); o.y = cvt_pk_bf16(bf_lo(sv[i].y) * er[2], bf_hi(sv[i].y) * er[3]);
                *(LAS u32x2*)(St + v * 136 + k4) = o;
            }
        }
        const int tb = w >> 1, hf = w & 1, tl = 16 * tb + fr;
        u32x2 gg[4];
#pragma unroll
        for (int i = 0; i < 4; ++i) gg[i] = *(const u32x2*)(proj + (t0 + tl) * PJ + 2048 + h * 128 + 16 * (4 * hf + i) + 4 * fq);
        const int cc_ = h * 128 + (tid & 31) * 4, tr = tid >> 5;
        u32x2 za[6], zb[6], cbv[4];
#pragma unroll
        for (int r = 0; r < 6; ++r) {
            const int tt = 4 * tr + r - 2;
            if (tt < 0 && n == 0) { za[r] = (u32x2){0u, 0u}; zb[r] = (u32x2){0u, 0u}; }
            else { const bf16_t* rp = proj + (size_t)((long)t0 + tt) * PJ; za[r] = *(const u32x2*)(rp + 4096 + cc_); zb[r] = *(const u32x2*)(rp + 5120 + cc_); }
        }
#pragma unroll
        for (int i = 0; i < 4; ++i) cbv[i] = *(const u32x2*)(proj + (t0 + 4 * tr + i) * PJ + 3072 + cc_);
        if (item + (int)gridDim.x < 4096) HG_LOAD_PRE(item + (int)gridDim.x);
        LDS_BARRIER();
#pragma unroll
        for (int s2 = 0; s2 < 2; ++s2) {
            const int st = 2 * hf + s2;
            f32x4 a4 = {0.f, 0.f, 0.f, 0.f};
            if (st <= tb) {
#pragma unroll
                for (int ks = 0; ks < 4; ++ks) {
                    const bf16x8 a = *(const LAS bf16x8*)(Ke + (16 * st + fr) * 136 + 32 * ks + 8 * fq);
                    const bf16x8 bq = *(const LAS bf16x8*)(Qe + tl * 136 + 32 * ks + 8 * fq);
                    a4 = __builtin_amdgcn_mfma_f32_16x16x32_bf16(a, bq, a4, 0, 0, 0);
                }
            }
            const int s0 = 16 * st + 4 * fq;
            u32x2 o; o.x = cvt_pk_bf16(s0 + 0 <= tl ? a4[0] : 0.f, s0 + 1 <= tl ? a4[1] : 0.f); o.y = cvt_pk_bf16(s0 + 2 <= tl ? a4[2] : 0.f, s0 + 3 <= tl ? a4[3] : 0.f);
            *(LAS u32x2*)(Pm + tl * 72 + s0) = o;
        }
        LDS_BARRIER();
        f32x4 ao[4];
#pragma unroll
        for (int i = 0; i < 4; ++i) ao[i] = (f32x4){0.f, 0.f, 0.f, 0.f};
#pragma unroll
        for (int ks = 0; ks < 4; ++ks) {
            const bf16x8 bq = *(const LAS bf16x8*)(Qe + tl * 136 + 32 * ks + 8 * fq);
#pragma unroll
            for (int i = 0; i < 4; ++i) { const bf16x8 a = *(const LAS bf16x8*)(St + (16 * (4 * hf + i) + fr) * 136 + 32 * ks + 8 * fq); ao[i] = __builtin_amdgcn_mfma_f32_16x16x32_bf16(a, bq, ao[i], 0, 0, 0); }
        }
#pragma unroll
        for (int ks = 0; ks < 2; ++ks) {
            const bf16x8 bq = *(const LAS bf16x8*)(Pm + tl * 72 + 32 * ks + 8 * fq);
#pragma unroll
            for (int i = 0; i < 4; ++i) { const bf16x8 a = *(const LAS bf16x8*)(Vt + (16 * (4 * hf + i) + fr) * 72 + 32 * ks + 8 * fq); ao[i] = __builtin_amdgcn_mfma_f32_16x16x32_bf16(a, bq, ao[i], 0, 0, 0); }
        }
        float ss = 0.f;
#pragma unroll
        for (int i = 0; i < 4; ++i)
#pragma unroll
            for (int j = 0; j < 4; ++j) ss += ao[i][j] * ao[i][j];
        ss += __shfl_xor(ss, 16); ss += __shfl_xor(ss, 32);
        if (fq == 0) ssq[tl * 2 + hf] = ss;
        LDS_BARRIER();
        const float rstd = rsqrtf((ssq[tl * 2] + ssq[tl * 2 + 1]) * (1.0f / 128.0f) + EPS);
#pragma unroll
        for (int i = 0; i < 4; ++i) {
            const int v0 = 16 * (4 * hf + i) + 4 * fq;
            const f32x4 nw = *(const f32x4*)(p.hgrn_norm_w + v0);
            u32x2 o;
            o.x = cvt_pk_bf16(ao[i][0] * rstd * nw[0] * silu_f(bf_lo(gg[i].x)), ao[i][1] * rstd * nw[1] * silu_f(bf_hi(gg[i].x)));
            o.y = cvt_pk_bf16(ao[i][2] * rstd * nw[2] * silu_f(bf_lo(gg[i].y)), ao[i][3] * rstd * nw[3] * silu_f(bf_hi(gg[i].y)));
            *(u32x2*)(mix + (t0 + tl) * D + h * 128 + v0) = o;
        }
        {
            const f32x4 w0 = *(const f32x4*)(p.sconv_w + cc_), w1 = *(const f32x4*)(p.sconv_w + 1024 + cc_), w2 = *(const f32x4*)(p.sconv_w + 2048 + cc_);
            f32x4 z[6];
#pragma unroll
            for (int r = 0; r < 6; ++r) z[r] = (f32x4){bf_lo(za[r].x) * bf_lo(zb[r].x), bf_hi(za[r].x) * bf_hi(zb[r].x), bf_lo(za[r].y) * bf_lo(zb[r].y), bf_hi(za[r].y) * bf_hi(zb[r].y)};
#pragma unroll
            for (int i = 0; i < 4; ++i) {
                const size_t t = t0 + 4 * tr + i;
                const f32x4 y = w0 * z[i] + w1 * z[i + 1] + w2 * z[i + 2];
                u32x2 o; o.x = cvt_pk_bf16(bf_lo(cbv[i].x) * y[0], bf_hi(cbv[i].x) * y[1]); o.y = cvt_pk_bf16(bf_lo(cbv[i].y) * y[2], bf_hi(cbv[i].y) * y[3]);
                *(u32x2*)(mix + t * D + 1024 + cc_) = o;
            }
        }
        LDS_BARRIER();
    }
#undef HG_LOAD_PRE
}

__device__ void phase_fixup(const Params& p) {
    const float* gf = (const float*)(p.ws + WS_GF); const float* uf = (const float*)(p.ws + WS_UF); const float* gl = (const float*)(p.ws + WS_GL);
    bf16_t* act = (bf16_t*)(p.ws + WS_ACT);
    const int per = FF / 4;
    for (int idx = blockIdx.x * 512 + threadIdx.x; idx < 512 * 2 * per; idx += gridDim.x * 512) {
        const int c = (idx % per) * 4, br = idx / per, r = br & 1, blk = br >> 1;
        const bool first = (blk & 127) == 0;
        const f32x4 zero = {0.f, 0.f, 0.f, 0.f};
        const f32x4 g0 = *(const f32x4*)(gf + ((size_t)blk * 2 + r) * FF + c);
        f32x4 g1, g2;
        if (r == 0) { g1 = first ? zero : *(const f32x4*)(gl + ((size_t)(blk - 1) * 2 + 1) * FF + c); g2 = first ? zero : *(const f32x4*)(gl + ((size_t)(blk - 1) * 2) * FF + c); }
        else { g1 = *(const f32x4*)(gf + ((size_t)blk * 2) * FF + c); g2 = first ? zero : *(const f32x4*)(gl + ((size_t)(blk - 1) * 2 + 1) * FF + c); }
        const f32x4 uu = *(const f32x4*)(uf + ((size_t)blk * 2 + r) * FF + c);
        const f32x4 w0 = *(const f32x4*)(p.ffn_conv_w + c), w1 = *(const f32x4*)(p.ffn_conv_w + FF + c), w2 = *(const f32x4*)(p.ffn_conv_w + 2 * FF + c), bb = *(const f32x4*)(p.ffn_conv_b + c);
        const f32x4 a = w2 * g0 + w1 * g1 + w0 * g2 + bb;
        u32x2 o; o.x = cvt_pk_bf16(silu_f(a[0]) * uu[0], silu_f(a[1]) * uu[1]); o.y = cvt_pk_bf16(silu_f(a[2]) * uu[2], silu_f(a[3]) * uu[3]);
        *(u32x2*)(act + ((size_t)blk * 64 + r) * FF + c) = o;
    }
}

__device__ void phase_final(const Params& p) {
    const int lane = threadIdx.x & 63, w = threadIdx.x >> 6;
    const bf16_t* x3 = (const bf16_t*)(p.ws + WS_B0);
    for (int r = blockIdx.x * 8 + w; r < T; r += gridDim.x * 8) {
        const bf16_t* src = x3 + (size_t)r * D;
        float* row = p.out + (size_t)r * D;
        u32x4 v[4]; float ss = 0.f;
#pragma unroll
        for (int i = 0; i < 4; ++i) {
            v[i] = *(const u32x4*)(src + i * 512 + lane * 8);
            const float a0 = bf_lo(v[i].x), a1 = bf_hi(v[i].x), a2 = bf_lo(v[i].y), a3 = bf_hi(v[i].y), a4 = bf_lo(v[i].z), a5 = bf_hi(v[i].z), a6 = bf_lo(v[i].w), a7 = bf_hi(v[i].w);
            ss += a0 * a0 + a1 * a1 + a2 * a2 + a3 * a3 + a4 * a4 + a5 * a5 + a6 * a6 + a7 * a7;
        }
        ss = wave_sum(ss);
        const float rstd = rsqrtf(ss * (1.0f / D) + EPS);
#pragma unroll
        for (int i = 0; i < 4; ++i) {
            const f32x4 g0 = *(const f32x4*)(p.final_norm_w + i * 512 + lane * 8), g1 = *(const f32x4*)(p.final_norm_w + i * 512 + lane * 8 + 4);
            f32x4 o0 = {bf_lo(v[i].x), bf_hi(v[i].x), bf_lo(v[i].y), bf_hi(v[i].y)}, o1 = {bf_lo(v[i].z), bf_hi(v[i].z), bf_lo(v[i].w), bf_hi(v[i].w)};
            *(f32x4*)(row + i * 512 + lane * 8) = o0 * rstd * g0; *(f32x4*)(row + i * 512 + lane * 8 + 4) = o1 * rstd * g1;
        }
    }
}

#define XB_TMO      128
#define XB_XCNT(j)  (256  + 64 * (j))
#define XB_XSUB(j)  (1280 + 64 * (j))
#define XB_XGEN(j)  (2304 + 64 * (j))
#define XB_TOP      3328
#define XB_TOPGEN   3392
#define XCD_BAR_WORDS 3456
#define XB_SPIN_CAP (1u << 21)
__device__ __forceinline__ unsigned xb_ld(unsigned* p)              { return __hip_atomic_load(p, __ATOMIC_RELAXED, __HIP_MEMORY_SCOPE_AGENT); }
__device__ __forceinline__ unsigned xb_add(unsigned* p, unsigned v) { return __hip_atomic_fetch_add(p, v, __ATOMIC_RELAXED, __HIP_MEMORY_SCOPE_AGENT); }
__device__ __forceinline__ unsigned xb_xcc_id() { return (unsigned)__builtin_amdgcn_s_getreg((3 << 11) | 20) & 0xFu; }
#define XB_SPIN(cond, bar) do { unsigned _sp = 0; while (cond) { __builtin_amdgcn_s_sleep(1); \
    if ((++_sp & 255u) == 0u) { if (xb_ld(&(bar)[XB_TMO])) break; if (_sp > XB_SPIN_CAP) { atomicAdd(&(bar)[XB_TMO], 1u); break; } } } } while (0)
struct XcdBarrier { unsigned* bar; unsigned x; volatile LAS unsigned* st; };
__device__ __forceinline__ XcdBarrier xcd_barrier_post(unsigned* bar, volatile LAS unsigned* st) {
    XcdBarrier b; b.bar = bar; b.x = xb_xcc_id(); b.st = st;
    if (threadIdx.x == 0) st[3] = xb_add(&bar[XB_XCNT(b.x)], 1u);
    return b;
}
__device__ __forceinline__ void xcd_barrier_complete(unsigned* bar, unsigned x, unsigned& nloc, unsigned& nx, unsigned& uni) {
    const unsigned G = gridDim.x * gridDim.y * gridDim.z;
    unsigned sum, cnt, mine, ok, sp = 0u;
    for (;;) {
        sum = 0u; cnt = 0u; mine = 0u; ok = 1u;
#pragma unroll
        for (unsigned j = 0; j < 16; ++j) { const unsigned c = xb_ld(&bar[XB_XCNT(j)]); sum += c; cnt += (c > 0u) ? 1u : 0u; mine = (j == x) ? c : mine; ok &= (c == (j < 8u ? G / 8u : 0u)) ? 1u : 0u; }
        if (sum == G) break;
        __builtin_amdgcn_s_sleep(1);
        if ((++sp & 255u) == 0u) { if (xb_ld(&bar[XB_TMO])) break; if (sp > XB_SPIN_CAP) { atomicAdd(&bar[XB_TMO], 1u); break; } }
    }
    nloc = mine > 0u ? mine : 1u; nx = cnt > 0u ? cnt : 1u; uni = (sum == G) ? ok : 0u;
}
__device__ __forceinline__ void xcd_barrier(const XcdBarrier& b) {
    asm volatile("s_waitcnt vmcnt(0)" ::: "memory");
    __syncthreads();
    if (threadIdx.x == 0) {
        unsigned* bar = b.bar;
        __builtin_amdgcn_s_waitcnt(0);
        unsigned nloc = b.st[0], nx = b.st[1];
        if (nloc == 0u) { unsigned uni; xcd_barrier_complete(bar, b.x, nloc, nx, uni); b.st[0] = nloc; b.st[1] = nx; b.st[2] = uni; }
        const unsigned old = xb_add(&bar[XB_XSUB(b.x)], 1u);
        const unsigned gen = old / nloc;
        if (old + 1u == (gen + 1u) * nloc) {
            __builtin_amdgcn_fence(__ATOMIC_RELEASE, "agent");
            asm volatile("s_waitcnt vmcnt(0)" ::: "memory");
            const unsigned og = xb_add(&bar[XB_TOP], 1u);
            const unsigned tg = og / nx;
            if (og + 1u == (tg + 1u) * nx) xb_add(&bar[XB_TOPGEN], 1u);
            else XB_SPIN(xb_ld(&bar[XB_TOPGEN]) == tg, bar);
            __builtin_amdgcn_fence(__ATOMIC_ACQUIRE, "agent");
            xb_add(&bar[XB_XGEN(b.x)], 1u);
            asm volatile("s_waitcnt vmcnt(0)" ::: "memory");
        } else {
            XB_SPIN(xb_ld(&bar[XB_XGEN(b.x)]) == gen, bar);
            __builtin_amdgcn_fence(__ATOMIC_ACQUIRE, "agent");
            asm volatile("s_waitcnt vmcnt(0)" ::: "memory");
        }
    }
    __syncthreads();
}

__global__ void __launch_bounds__(512) fwd_megakernel(Params p) {
    extern __shared__ __attribute__((aligned(16))) unsigned char smem[];
    LAS unsigned char* lds = (LAS unsigned char*)smem;
    unsigned char* ws = p.ws;
    bf16_t* const H = (bf16_t*)(ws + WS_H); bf16_t* const B0 = (bf16_t*)(ws + WS_B0); bf16_t* const B1 = (bf16_t*)(ws + WS_B1); bf16_t* const B2 = (bf16_t*)(ws + WS_B2);
    float* const rss2 = (float*)(ws + WS_RSS2); float* const rss3 = (float*)(ws + WS_RSS3);
#define RUN(k) (PH_ON(k) && p.ph_lo <= (k) && (k) <= p.ph_hi)
    volatile LAS unsigned* stw = (volatile LAS unsigned*)(lds + STAGE_BYTES + 8192);
    if (threadIdx.x < 4) stw[threadIdx.x] = 0u;
    __syncthreads();
    XcdBarrier xbar; xbar.bar = (unsigned*)(ws + WS_BAR); xbar.x = 0u; xbar.st = stw;
    if (p.ph_lo < p.ph_hi) xbar = xcd_barrier_post((unsigned*)(ws + WS_BAR), stw);
    if (p.ph_hi > 1000) cg::this_grid().sync();
#define SEAM(k) do { if (p.ph_lo <= (k) && (k) < p.ph_hi) xcd_barrier(xbar); } while (0)
    if (RUN(0)) { phase_prep(p, lds); }
    SEAM(0);
    int vcu = blockIdx.x;
    if (p.ph_lo < p.ph_hi && p.ph_lo == 0 && gridDim.x == 256 && stw[2] != 0u && stw[3] < 32u && xbar.x < 8u) vcu = (int)(stw[3] * 8u + xbar.x);
    vcu = __builtin_amdgcn_readfirstlane(vcu);
    if (RUN(1)) {
        { pg8::Gemm g{H, (const bf16_t*)(ws + WS_WIN), D, D, D}; pg8::Order S; S.init(vcu, T / 256, INC / 256, 0, D, D);
          pg8::EpiIn E{B0, (float*)(ws + WS_LOGF), (const float*)(ws + WS_LB)}; pg8::gemm_phase(lds, g, S, E); }
    }
    SEAM(1);
    if (RUN(2)) {
        { pg8::Gemm g{(const bf16_t*)(ws + WS_MEMN), (const bf16_t*)(ws + WS_WK), D, D, D}; pg8::Order S; S.init(vcu, 4, 16, 0, D, D);
          pg8::EpiB E{(bf16_t*)(ws + WS_KP), 2 * D, nullptr}; pg8::gemm_phase(lds, g, S, E); }
        phase_hgrn_local(p, lds, vcu);
    }
    SEAM(2);
    if (RUN(3)) {
        { pg8::Gemm g{(const bf16_t*)(ws + WS_KP), (const bf16_t*)(ws + WS_WQ), 2 * D, D, 512}; pg8::Order S; S.init(vcu, 16, 8, 3, 2 * D, D);
          pg8::EpiB E{(bf16_t*)(ws + WS_WQK), D, nullptr}; pg8::gemm_phase(lds, g, S, E); }
        { pg8::Gemm g{(const bf16_t*)(ws + WS_WO), (const bf16_t*)(ws + WS_KP), D, 2 * D, 512}; pg8::Order S; S.init(vcu, 32, 4, 4, D, 2 * D, 128);
          pg8::EpiB E{(bf16_t*)(ws + WS_WVO), 1024, nullptr}; pg8::gemm_phase(lds, g, S, E); }
        phase_hgrn_scan(p);
    }
    SEAM(3);
    if (RUN(4)) { phase_hgrn_out(p, lds); }
    SEAM(4);
    if (RUN(5)) {
        pg8::Gemm g{H, (const bf16_t*)(ws + WS_WOUT), D, D, D}; pg8::Order S; S.init(vcu, T / 256, D / 256, 0, D, D);
        pg8::EpiRes<false, false, true, true> E{p.x, nullptr, B0, rss2}; pg8::gemm_phase(lds, g, S, E);
    }
    SEAM(5);
    if (RUN(6)) {
        phase_ffn_weights(p, lds);
        pg8::Gemm g{B0, (const bf16_t*)(ws + WS_WQK), D, D, D}; pg8::Order S; S.init(vcu, T / 256, 4, 5, D, D);
        pg8::EpiSm E{B2, (LAS float*)(lds + STAGE_BYTES), rss2}; pg8::gemm_phase(lds, g, S, E);
    }
    SEAM(6);
    if (RUN(7)) {
        pg8::Gemm g{B2, (const bf16_t*)(ws + WS_WVO), 1024, 1024, 1024}; pg8::Order S; S.init(vcu, T / 256, D / 256, 6, 1024, 1024);
        pg8::EpiRes<true, false, true, true> E{B0, nullptr, B0, rss3}; pg8::gemm_phase(lds, g, S, E);
    }
    SEAM(7);
    if (RUN(8)) {
        pg8::Gemm g{B0, (const bf16_t*)(ws + WS_WGU), D, D, D}; pg8::Order S; S.init(vcu, T / 256, 2 * FF / 256, 0, D, D);
        pg8::EpiGu E{(bf16_t*)(ws + WS_ACT), rss3, p.ffn_conv_w, p.ffn_conv_b, (float*)(ws + WS_GF), (float*)(ws + WS_UF), (float*)(ws + WS_GL)}; pg8::gemm_phase(lds, g, S, E);
    }
    SEAM(8);
    if (RUN(9)) { phase_fixup(p); }
    SEAM(9);
    if (RUN(10)) {
        pg8::Gemm g{(const bf16_t*)(ws + WS_ACT), (const bf16_t*)(ws + WS_WDN), FF, FF, FF}; pg8::Order S; S.init(vcu, T / 256, D / 256, 0, FF, FF);
        pg8::EpiRes<true, false, true, false> E{B0, nullptr, B0, nullptr}; pg8::gemm_phase(lds, g, S, E);
    }
    SEAM(10);
    if (RUN(11)) { phase_final(p); }
}

extern "C" void kernel_launch(void* const* d_in, const int* in_sizes, int n_in, void* d_out, int out_size, void* d_ws, size_t ws_size, hipStream_t stream) {
    static int grid = 0;
    if (grid == 0) {
        if (n_in != 21 || ws_size < WS_END) { fprintf(stderr, "kernel_launch: unexpected inputs (%d) or workspace (%zu < %zu)\n", n_in, ws_size, (size_t)WS_END); grid = -1; return; }
        int dev = 0, cus = 0, per_cu = 0;
        hipGetDevice(&dev);
        hipDeviceGetAttribute(&cus, hipDeviceAttributeMultiprocessorCount, dev);
        if (hipFuncSetAttribute((const void*)fwd_megakernel, hipFuncAttributeMaxDynamicSharedMemorySize, LDS_BYTES) != hipSuccess) { fprintf(stderr, "kernel_launch: hipFuncSetAttribute failed\n"); grid = -1; return; }
        if (hipOccupancyMaxActiveBlocksPerMultiprocessor(&per_cu, (const void*)fwd_megakernel, 512, LDS_BYTES) != hipSuccess || per_cu < 1) { (void)hipGetLastError(); per_cu = 1; }
        grid = cus * per_cu;
    }
    if (grid < 0) return;
    Params p{};
    const float** f = (const float**)&p;
    for (int i = 0; i < 21; ++i) f[i] = (const float*)d_in[i];
    p.out = (float*)d_out; p.ws = (unsigned char*)d_ws;
#if MULTI_LAUNCH
    for (int ph = 0; ph < NPHASE; ++ph) {
        p.ph_lo = ph; p.ph_hi = ph;
        hipLaunchKernelGGL(fwd_megakernel, dim3(grid), dim3(512), LDS_BYTES, stream, p);
    }
#else
    p.ph_lo = 0; p.ph_hi = NPHASE - 1;
    if (hipMemsetAsync((char*)d_ws + WS_BAR, 0, XCD_BAR_WORDS * 4, stream) != hipSuccess) { fprintf(stderr, "kernel_launch: hipMemsetAsync failed\n"); return; }
    void* args[] = {&p};
    hipError_t e = hipLaunchCooperativeKernel((const void*)fwd_megakernel, dim3(grid), dim3(512), args, LDS_BYTES, stream);
    if (e != hipSuccess) fprintf(stderr, "cooperative launch failed: %s (grid %d)\n", hipGetErrorString(e), grid);
#endif
}
```

```cpp
#include <hip/hip_runtime.h>
#include <hip/hip_cooperative_groups.h>
#include <cstdio>
namespace cg = cooperative_groups;

#ifndef MULTI_LAUNCH
#define MULTI_LAUNCH 0
#endif

#ifndef ONLY_PHASE
#define ONLY_PHASE -1
#endif
#define PH_ON(k) (ONLY_PHASE < 0 || ONLY_PHASE == (k))

#define LAS __attribute__((address_space(3)))
typedef unsigned short bf16_t;
typedef short bf16x8 __attribute__((ext_vector_type(8)));
typedef float f32x4 __attribute__((ext_vector_type(4)));
typedef float f32x2 __attribute__((ext_vector_type(2)));
typedef unsigned u32x4 __attribute__((ext_vector_type(4)));
typedef unsigned u32x2 __attribute__((ext_vector_type(2)));

constexpr int T = 32768, D = 2048, SEQ = 8192;
constexpr int INC = 7168, PJ = 6144;
constexpr int FF = 5632;
constexpr float EPS = 1e-6f;
constexpr int NPHASE = 12;

constexpr size_t SZ_TD2 = (size_t)T * D * 2;
constexpr size_t WS_WIN = 0;
constexpr size_t WS_WOUT = WS_WIN + (size_t)INC * D * 2;
constexpr size_t WS_WQ = WS_WOUT + (size_t)D * D * 2;
constexpr size_t WS_WK = WS_WQ + (size_t)D * D * 2;
constexpr size_t WS_WV = WS_WK + (size_t)D * D * 2;
constexpr size_t WS_WO = WS_WV + (size_t)D * D * 2;
constexpr size_t WS_H = WS_WO + (size_t)D * D * 2;
constexpr size_t WS_B0 = WS_H + SZ_TD2;
constexpr size_t WS_B1 = WS_B0 + SZ_TD2;
constexpr size_t WS_B2 = WS_B1 + SZ_TD2;
constexpr size_t WS_LOGF = WS_B2 + SZ_TD2;
constexpr size_t WS_US = WS_LOGF + SZ_TD2;
constexpr size_t WS_MEMN = WS_US + (size_t)4096 * 16384 * 4;
constexpr size_t WS_KP = WS_MEMN + (size_t)1024 * D * 2;
constexpr size_t WS_VT = WS_KP + (size_t)1024 * D * 2;
constexpr size_t WS_DEC = WS_VT + (size_t)1024 * D * 2;
constexpr size_t WS_RSS2 = WS_DEC + (size_t)4096 * 128 * 4;
constexpr size_t WS_RSS3 = WS_RSS2 + (size_t)T * 4;
constexpr size_t WS_LB = WS_RSS3 + (size_t)T * 4;
constexpr size_t WS_WQK = WS_LB + 4096;
constexpr size_t WS_WVO = WS_WQK + (size_t)4 * 1024 * D * 2;
constexpr size_t WS_BAR = WS_WVO + (size_t)4 * D * 1024 * 2;
constexpr size_t WS_END = WS_BAR + 16384;
constexpr size_t WS_WGU = WS_US;
constexpr size_t WS_WDN = WS_US + (size_t)2 * FF * D * 2;
constexpr size_t WS_ACT = WS_B1;
constexpr size_t SZ_HALO = (size_t)512 * 2 * FF * 4;
constexpr size_t WS_GF = WS_H, WS_UF = WS_H + SZ_HALO, WS_GL = WS_H + 2 * SZ_HALO;
static_assert(WS_ACT + (size_t)T * FF * 2 <= WS_US, "act overlaps FFN weights");
static_assert(3 * SZ_HALO <= SZ_TD2, "halo");
static_assert(WS_END <= (size_t)1 << 30, "workspace");

constexpr int STAGE_BYTES = 131072;
constexpr int LDS_BYTES = STAGE_BYTES + 8192 + 16;

struct Params {
    const float* x; const float* mem; const float* hgrn_lb; const float* norm1_w; const float* w_in; const float* hgrn_norm_w; const float* sconv_w;
    const float* w_out; const float* norm2_w; const float* mem_norm_w; const float* wq; const float* wk; const float* wv; const float* wo;
    const float* norm3_w; const float* w_gate; const float* w_up; const float* ffn_conv_w; const float* ffn_conv_b; const float* w_down; const float* final_norm_w;
    float* out; unsigned char* ws; int ph_lo, ph_hi;
};

typedef __bf16 bf16x2_t __attribute__((ext_vector_type(2)));
__device__ __forceinline__ unsigned cvt_pk_bf16_c(float lo, float hi) { const f32x2 v = {lo, hi}; return __builtin_bit_cast(unsigned, __builtin_convertvector(v, bf16x2_t)); }
__device__ __forceinline__ unsigned cvt_pk_bf16(float lo, float hi) { unsigned r; asm volatile("v_cvt_pk_bf16_f32 %0, %1, %2" : "=v"(r) : "v"(lo), "v"(hi)); return r; }
__device__ __forceinline__ float bf_lo(unsigned u) { return __uint_as_float(u << 16); }
__device__ __forceinline__ float bf_hi(unsigned u) { return __uint_as_float(u & 0xffff0000u); }
__device__ __forceinline__ float silu_f(float v) { return v * __builtin_amdgcn_rcpf(1.0f + __expf(-v)); }
__device__ __forceinline__ float wave_sum(float v) {
#pragma unroll
    for (int o = 32; o >= 1; o >>= 1) v += __shfl_xor(v, o);
    return v;
}

namespace pg8 {
constexpr int BM = 256, BK = 64, HALF = 128, HTB = HALF * BK * 2, NXCD = 8, WGM = 8;
__host__ __device__ __forceinline__ int lds_byte(int r, int c) { const int st = (r >> 4) * 2 + (c >> 5), rr = r & 15, cc = c & 31, ob = rr * 64 + cc * 2; return st * 1024 + (ob ^ (((ob >> 9) & 1) << 5)); }
__host__ __device__ __forceinline__ void stage_rc(int b, int& R, int& C) { const int st = b / 1024, sb = b % 1024, swz = sb ^ (((sb >> 9) & 1) << 5); R = (st >> 1) * 16 + swz / 64; C = (st & 1) * 32 + (swz % 64) / 2; }
__host__ __device__ __forceinline__ int perm32(int rho) { const int n = rho >> 4, i = rho & 15; return 8 * (i >> 2) + 4 * n + (i & 3); }

struct Unit { size_t aoff, boff; int pm, pn; };
struct Gemm { const bf16_t* A; const bf16_t* Bt; int lda, ldb, K; };

struct Order {
    int nM, nN, nwg, G, c, mode; size_t lda2, ldb2;
    __device__ void init(int nM_, int nN_, int mode_, int lda, int ldb, int crot = 0) { nM = nM_; nN = nN_; nwg = nM * nN; G = gridDim.x; c = (int)((blockIdx.x + crot) % gridDim.x); mode = mode_; lda2 = (size_t)lda * 2; ldb2 = (size_t)ldb * 2; }
    __device__ bool next(int i, Unit& u) const {
        const long L = (long)i * G + c; if (L >= nwg) return false;
        int wgid = (int)L; { const int q = nwg / NXCD, r = nwg % NXCD, xcd = wgid % NXCD, off = wgid / NXCD; wgid = (xcd < r ? xcd * (q + 1) : r * (q + 1) + (xcd - r) * q) + off; }
        const int nig = WGM * nN, gid = wgid / nig, fm = gid * WGM, gsz = (nM - fm) < WGM ? (nM - fm) : WGM;
        const int pm = fm + ((wgid % nig) % gsz), pn = (wgid % nig) / gsz;
        u.pm = pm; u.pn = pn;
        if (mode == 0) { u.aoff = (size_t)pm * 256 * lda2; u.boff = (size_t)pn * 256 * ldb2; }
        else if (mode == 3) { const int b = pm >> 2, h = pm & 3; u.aoff = (size_t)(b * 256) * lda2 + (size_t)h * 1024; u.boff = (size_t)pn * 256 * ldb2 + (size_t)h * 1024; }
        else if (mode == 4) { const int b = pm >> 3, nt_ = pm & 7, h = pn; u.aoff = (size_t)(nt_ * 256) * lda2 + (size_t)h * 1024; u.boff = (size_t)(b * 256) * ldb2 + (size_t)(2048 + h * 512) * 2; }
        else if (mode == 5) { const int b = pm >> 5; u.aoff = (size_t)pm * 256 * lda2; u.boff = (size_t)(b * 1024 + pn * 256) * ldb2; }
        else { const int b = pm >> 5; u.aoff = (size_t)pm * 256 * lda2; u.boff = (size_t)(b * 2048 + pn * 256) * ldb2; }
        return true;
    }
};

template <class Epi>
__device__ __forceinline__ void gemm_phase(LAS unsigned char* lds, const Gemm g, const Order& S, const Epi& E) {
    const int tid = threadIdx.x, wid = __builtin_amdgcn_readfirstlane(tid >> 6), lane = tid & 63, wr = wid >> 2, wc = wid & 3, fr = lane & 15, fq = lane >> 4;
    const int K = g.K, nt = K / BK;
    unsigned voffA[2], voffB[2];
#pragma unroll
    for (int i = 0; i < 2; ++i) { int R, C; stage_rc(tid * 16 + i * 8192, R, C); const int Rb = Epi::PERM ? ((R & ~31) + perm32(R & 31)) : R;
        voffA[i] = (unsigned)(R * g.lda + C) * 2u; voffB[i] = (unsigned)(Rb * g.ldb + C) * 2u; }
    const size_t kstep = (size_t)(BK * 2);
    const size_t hstepA = (size_t)HALF * g.lda * 2, hstepB = (size_t)HALF * g.ldb * 2;
    const unsigned ldsw = (unsigned)wid * 1024u;
    const int aoff = lds_byte(wr * 64 + fr, fq * 8), boff = lds_byte(wc * 32 + fr, fq * 8);
#define PG8_SA(b, h) (((b) * 2 + (h)) * HTB)
#define PG8_SB(b, h) ((4 + (b) * 2 + (h)) * HTB)
#define PG8_STAGE(bufoff, gbase, voff) do { _Pragma("unroll") for (int _i = 0; _i < 2; ++_i) \
        __builtin_amdgcn_global_load_lds((const unsigned*)((const char*)(gbase) + (voff)[_i]), (LAS unsigned*)(lds + (bufoff) + ldsw + _i * 8192), 16, 0, 0); } while (0)
#define PG8_LDA(dst, b, h) do { _Pragma("unroll") for (int m = 0; m < 4; ++m) _Pragma("unroll") for (int k = 0; k < 2; ++k) dst[m][k] = *(const LAS bf16x8*)(lds + PG8_SA(b, h) + aoff + m * 2048 + k * 1024); } while (0)
#define PG8_LDB(dst, b, h) do { _Pragma("unroll") for (int n = 0; n < 2; ++n) _Pragma("unroll") for (int k = 0; k < 2; ++k) dst[n][k] = *(const LAS bf16x8*)(lds + PG8_SB(b, h) + boff + n * 2048 + k * 1024); } while (0)
#define PG8_MMA(ai, bj, At, Bt) do { __builtin_amdgcn_s_setprio(1); _Pragma("unroll") for (int m = 0; m < 4; ++m) _Pragma("unroll") for (int n = 0; n < 2; ++n) _Pragma("unroll") for (int k = 0; k < 2; ++k) \
        acc[ai][bj][m][n] = __builtin_amdgcn_mfma_f32_16x16x32_bf16(Bt[n][k], At[m][k], acc[ai][bj][m][n], 0, 0, 0); __builtin_amdgcn_s_setprio(0); } while (0)
#define PG8_WAIT_V(n) asm volatile("s_waitcnt vmcnt(" #n ")" ::: "memory")
#define PG8_WAIT_L(n) asm volatile("s_waitcnt lgkmcnt(" #n ")" ::: "memory")
#define PG8_BAR __builtin_amdgcn_s_barrier()
#define PG8_SCHED __builtin_amdgcn_sched_barrier(0)
    Unit cur, nxt; int ui = 0;
    if (!S.next(0, cur)) return;
    f32x4 acc[2][2][4][2];
#pragma unroll
    for (int a = 0; a < 2; ++a)
#pragma unroll
        for (int b = 0; b < 2; ++b)
#pragma unroll
            for (int m = 0; m < 4; ++m)
#pragma unroll
                for (int n = 0; n < 2; ++n) acc[a][b][m][n] = (f32x4){0.f, 0.f, 0.f, 0.f};
    bf16x8 At[4][2], B0[2][2], B1[2][2];
    const char* cA = (const char*)g.A + cur.aoff; const char* cB = (const char*)g.Bt + cur.boff;
    PG8_STAGE(PG8_SB(0, 0), cB, voffB); PG8_STAGE(PG8_SB(0, 1), cB + hstepB, voffB); PG8_STAGE(PG8_SA(0, 0), cA, voffA); PG8_STAGE(PG8_SA(0, 1), cA + hstepA, voffA);
    if (wr == 1) PG8_BAR;
    PG8_WAIT_V(2); PG8_BAR;
    PG8_STAGE(PG8_SB(1, 0), cB + kstep, voffB); PG8_STAGE(PG8_SA(1, 0), cA + kstep, voffA); PG8_STAGE(PG8_SB(1, 1), cB + hstepB + kstep, voffB);
    PG8_WAIT_V(6); PG8_BAR;
    for (;;) {
        const bool has_next = S.next(ui + 1, nxt);
        const char* nA = has_next ? (const char*)g.A + nxt.aoff : cA; const char* nB = has_next ? (const char*)g.Bt + nxt.boff : cB;
        for (int t = 0; t < nt; t += 2) {
            const bool last = (t == nt - 2);
            const char* a1 = cA + (size_t)(t + 1) * kstep;
            const char* a2 = last ? nA : cA + (size_t)(t + 2) * kstep; const char* b2 = last ? nB : cB + (size_t)(t + 2) * kstep;
            const char* a3 = a2 + kstep; const char* b3 = b2 + kstep;
            PG8_LDB(B0, 0, 0); PG8_LDB(B1, 0, 1); PG8_SCHED; PG8_LDA(At, 0, 0); PG8_STAGE(PG8_SA(1, 1), a1 + hstepA, voffA);
            PG8_WAIT_V(8); PG8_WAIT_L(0); PG8_BAR; PG8_MMA(0, 0, At, B0); PG8_MMA(0, 1, At, B1); PG8_BAR; PG8_SCHED;
            PG8_LDA(At, 0, 1); PG8_STAGE(PG8_SB(0, 0), b2, voffB); PG8_STAGE(PG8_SB(0, 1), b2 + hstepB, voffB); PG8_STAGE(PG8_SA(0, 0), a2, voffA);
            PG8_WAIT_V(8); PG8_WAIT_L(0); PG8_BAR; PG8_MMA(1, 0, At, B0); PG8_MMA(1, 1, At, B1); PG8_BAR; PG8_SCHED;
            PG8_LDB(B0, 1, 0); PG8_LDB(B1, 1, 1); PG8_SCHED; PG8_LDA(At, 1, 0); PG8_STAGE(PG8_SA(0, 1), a2 + hstepA, voffA);
            PG8_WAIT_V(8); PG8_WAIT_L(0); PG8_BAR; PG8_MMA(0, 0, At, B0); PG8_MMA(0, 1, At, B1); PG8_BAR; PG8_SCHED;
            PG8_LDA(At, 1, 1); PG8_STAGE(PG8_SB(1, 0), b3, voffB); PG8_STAGE(PG8_SB(1, 1), b3 + hstepB, voffB); PG8_STAGE(PG8_SA(1, 0), a3, voffA);
            PG8_WAIT_V(8); PG8_WAIT_L(0); PG8_BAR; PG8_MMA(1, 0, At, B0); PG8_MMA(1, 1, At, B1); PG8_BAR; PG8_SCHED;
        }
        if (wr == 0) PG8_BAR;
        E(acc, cur, wr, wc, fr, fq);
        if (!has_next) break;
#pragma unroll
        for (int a = 0; a < 2; ++a)
#pragma unroll
            for (int b = 0; b < 2; ++b)
#pragma unroll
                for (int m = 0; m < 4; ++m)
#pragma unroll
                    for (int n = 0; n < 2; ++n) acc[a][b][m][n] = (f32x4){0.f, 0.f, 0.f, 0.f};
        cur = nxt; cA = nA; cB = nB; ++ui;
        if (wr == 1) PG8_BAR;
    }
    PG8_WAIT_V(0);
    PG8_BAR;
#undef PG8_SA
#undef PG8_SB
#undef PG8_STAGE
#undef PG8_LDA
#undef PG8_LDB
#undef PG8_MMA
#undef PG8_WAIT_V
#undef PG8_WAIT_L
#undef PG8_BAR
#undef PG8_SCHED
}

typedef f32x4 Acc[2][2][4][2];

struct EpiIn {
    static constexpr bool PERM = true;
    bf16_t* proj; float* logf; const float* lb;
    __device__ __forceinline__ void operator()(Acc& acc, const Unit& u, int wr, int wc, int fr, int fq) const {
        const int row0 = u.pm * 256 + wr * 64 + fr, sec = u.pn >> 2, colt = u.pn * 256 + wc * 32 + 8 * fq;
        if (sec == 1) {
#pragma unroll
            for (int bj = 0; bj < 2; ++bj) {
                const int c = colt + bj * 128 - 1024;
                const f32x4 l0 = *(const f32x4*)(lb + c), l1 = *(const f32x4*)(lb + c + 4);
#pragma unroll
                for (int ai = 0; ai < 2; ++ai)
#pragma unroll
                    for (int m = 0; m < 4; ++m) {
                        const size_t row = (size_t)(row0 + ai * 128 + m * 16);
                        f32x4 o0, o1;
#pragma unroll
                        for (int j = 0; j < 4; ++j) {
                            const float s0 = __builtin_amdgcn_rcpf(1.0f + __expf(-acc[ai][bj][m][0][j])), s1 = __builtin_amdgcn_rcpf(1.0f + __expf(-acc[ai][bj][m][1][j]));
                            o0[j] = __logf(l0[j] + (1.0f - l0[j]) * s0); o1[j] = __logf(l1[j] + (1.0f - l1[j]) * s1);
                        }
                        float* dst = logf + row * 1024 + c;
                        *(f32x4*)dst = o0; *(f32x4*)(dst + 4) = o1;
                    }
            }
        } else {
            const int cb = (sec == 0) ? colt : colt - 1024;
#pragma unroll
            for (int ai = 0; ai < 2; ++ai)
#pragma unroll
                for (int m = 0; m < 4; ++m) {
                    bf16_t* rowp = proj + (size_t)(row0 + ai * 128 + m * 16) * PJ + cb;
#pragma unroll
                    for (int bj = 0; bj < 2; ++bj) {
                        f32x4 v0 = acc[ai][bj][m][0], v1 = acc[ai][bj][m][1];
                        if (sec == 0) {
#pragma unroll
                            for (int j = 0; j < 4; ++j) { v0[j] = silu_f(v0[j]); v1[j] = silu_f(v1[j]); }
                        }
                        u32x4 w; w.x = cvt_pk_bf16(v0[0], v0[1]); w.y = cvt_pk_bf16(v0[2], v0[3]); w.z = cvt_pk_bf16(v1[0], v1[1]); w.w = cvt_pk_bf16(v1[2], v1[3]);
                        *(u32x4*)(rowp + bj * 128) = w;
                    }
                }
        }
    }
};

struct EpiB {
    static constexpr bool PERM = true;
    bf16_t* O; int ldc; const float* rss;
    __device__ __forceinline__ void operator()(Acc& acc, const Unit& u, int wr, int wc, int fr, int fq) const {
        const int row0 = u.pm * 256 + wr * 64 + fr, col0 = u.pn * 256 + wc * 32 + 8 * fq;
#pragma unroll
        for (int ai = 0; ai < 2; ++ai)
#pragma unroll
            for (int m = 0; m < 4; ++m) {
                const int row = row0 + ai * 128 + m * 16;
                const float s = rss ? rsqrtf(rss[row] * (1.0f / D) + EPS) : 1.0f;
                bf16_t* rowp = O + (size_t)row * ldc + col0;
#pragma unroll
                for (int bj = 0; bj < 2; ++bj) {
                    const f32x4 v0 = acc[ai][bj][m][0] * s, v1 = acc[ai][bj][m][1] * s;
                    u32x4 w; w.x = cvt_pk_bf16(v0[0], v0[1]); w.y = cvt_pk_bf16(v0[2], v0[3]); w.z = cvt_pk_bf16(v1[0], v1[1]); w.w = cvt_pk_bf16(v1[2], v1[3]);
                    *(u32x4*)(rowp + bj * 128) = w;
                }
            }
    }
};

template <bool XIN_BF16, bool OUT_F32, bool OUT_B, bool RSS> struct EpiRes {
    static constexpr bool PERM = true;
    const void* xin; float* xout; bf16_t* xb; float* rss;
    __device__ __forceinline__ void operator()(Acc& acc, const Unit& u, int wr, int wc, int fr, int fq) const {
        const int row0 = u.pm * 256 + wr * 64 + fr, col0 = u.pn * 256 + wc * 32 + 8 * fq;
#pragma unroll
        for (int ai = 0; ai < 2; ++ai) {
            f32x4 xi[4][2][2];
#pragma unroll
            for (int m = 0; m < 4; ++m)
#pragma unroll
                for (int bj = 0; bj < 2; ++bj) {
                    const size_t o = (size_t)(row0 + ai * 128 + m * 16) * D + col0 + bj * 128;
                    if (XIN_BF16) { const u32x4 r = *(const u32x4*)((const bf16_t*)xin + o);
                        xi[m][bj][0] = (f32x4){bf_lo(r.x), bf_hi(r.x), bf_lo(r.y), bf_hi(r.y)}; xi[m][bj][1] = (f32x4){bf_lo(r.z), bf_hi(r.z), bf_lo(r.w), bf_hi(r.w)}; }
                    else { xi[m][bj][0] = *(const f32x4*)((const float*)xin + o); xi[m][bj][1] = *(const f32x4*)((const float*)xin + o + 4); }
                }
#pragma unroll
            for (int m = 0; m < 4; ++m) {
                const size_t row = (size_t)(row0 + ai * 128 + m * 16);
                float ss = 0.f;
#pragma unroll
                for (int bj = 0; bj < 2; ++bj) {
                    const size_t o = row * D + col0 + bj * 128;
                    const f32x4 v0 = acc[ai][bj][m][0] + xi[m][bj][0], v1 = acc[ai][bj][m][1] + xi[m][bj][1];
                    if (OUT_F32) { *(f32x4*)(xout + o) = v0; *(f32x4*)(xout + o + 4) = v1; }
                    if (OUT_B) {
                        u32x4 w; w.x = cvt_pk_bf16(v0[0], v0[1]); w.y = cvt_pk_bf16(v0[2], v0[3]); w.z = cvt_pk_bf16(v1[0], v1[1]); w.w = cvt_pk_bf16(v1[2], v1[3]);
                        *(u32x4*)(xb + o) = w;
                        if (RSS) {
#pragma unroll
                            for (int j = 0; j < 4; ++j) ss += v0[j] * v0[j] + v1[j] * v1[j];
                        }
                    }
                }
                if (RSS) { ss += __shfl_xor(ss, 16); ss += __shfl_xor(ss, 32); if (fq == 0) atomicAdd(rss + row, ss); }
            }
        }
    }
};

struct EpiSm {
    static constexpr bool PERM = true;
    bf16_t* P; LAS float* xl; const float* rss;
    __device__ __forceinline__ void operator()(Acc& acc, const Unit& u, int wr, int wc, int fr, int fq) const {
        const float sc0 = 0.044194173824159216f * 1.4426950408889634f;
        const int rl0 = wr * 64 + fr;
        const int rowg0 = u.pm * 256 + wr * 64 + fr;
#pragma unroll
        for (int ai = 0; ai < 2; ++ai)
#pragma unroll
            for (int m = 0; m < 4; ++m) {
                float mx = -3.0e38f;
#pragma unroll
                for (int bj = 0; bj < 2; ++bj)
#pragma unroll
                    for (int n = 0; n < 2; ++n)
#pragma unroll
                        for (int j = 0; j < 4; ++j) mx = fmaxf(mx, acc[ai][bj][m][n][j]);
                mx = fmaxf(mx, __shfl_xor(mx, 16)); mx = fmaxf(mx, __shfl_xor(mx, 32));
                if (fq == 0) xl[(rl0 + ai * 128 + m * 16) * 4 + wc] = mx;
            }
        asm volatile("s_waitcnt lgkmcnt(0)" ::: "memory"); __builtin_amdgcn_s_barrier(); asm volatile("" ::: "memory");
#pragma unroll
        for (int ai = 0; ai < 2; ++ai)
#pragma unroll
            for (int m = 0; m < 4; ++m) {
                const int rl = rl0 + ai * 128 + m * 16;
                const f32x4 mm = *(const LAS f32x4*)(xl + rl * 4);
                const float sc = sc0 * rsqrtf(rss[rowg0 + ai * 128 + m * 16] * (1.0f / D) + EPS);
                const float M = fmaxf(fmaxf(mm[0], mm[1]), fmaxf(mm[2], mm[3])) * sc;
                float sum = 0.f;
#pragma unroll
                for (int bj = 0; bj < 2; ++bj)
#pragma unroll
                    for (int n = 0; n < 2; ++n)
#pragma unroll
                        for (int j = 0; j < 4; ++j) { const float pv = exp2f(acc[ai][bj][m][n][j] * sc - M); acc[ai][bj][m][n][j] = pv; sum += pv; }
                sum += __shfl_xor(sum, 16); sum += __shfl_xor(sum, 32);
                if (fq == 0) xl[1024 + rl * 4 + wc] = sum;
            }
        asm volatile("s_waitcnt lgkmcnt(0)" ::: "memory"); __builtin_amdgcn_s_barrier(); asm volatile("" ::: "memory");
        const int row0 = u.pm * 256 + wr * 64 + fr, col0 = u.pn * 256 + wc * 32 + 8 * fq;
#pragma unroll
        for (int ai = 0; ai < 2; ++ai)
#pragma unroll
            for (int m = 0; m < 4; ++m) {
                const int rl = rl0 + ai * 128 + m * 16;
                const f32x4 ss = *(const LAS f32x4*)(xl + 1024 + rl * 4);
                const float inv = 1.0f / (ss[0] + ss[1] + ss[2] + ss[3]);
                bf16_t* rowp = P + (size_t)(row0 + ai * 128 + m * 16) * 1024 + col0;
#pragma unroll
                for (int bj = 0; bj < 2; ++bj) {
                    const f32x4 v0 = acc[ai][bj][m][0] * inv, v1 = acc[ai][bj][m][1] * inv;
                    u32x4 w; w.x = cvt_pk_bf16(v0[0], v0[1]); w.y = cvt_pk_bf16(v0[2], v0[3]); w.z = cvt_pk_bf16(v1[0], v1[1]); w.w = cvt_pk_bf16(v1[2], v1[3]);
                    *(u32x4*)(rowp + bj * 128) = w;
                }
            }
    }
};

struct EpiGu {
    static constexpr bool PERM = true;
    bf16_t* act; const float* rss; const float* cw; const float* cbias; float* gf; float* uf; float* gl;
    __device__ __forceinline__ void operator()(Acc& acc, const Unit& u, int wr, int wc, int fr, int fq) const {
        const int row0 = u.pm * 256 + wr * 64 + fr, c0 = u.pn * 128 + wc * 32 + 8 * fq;
#pragma unroll
        for (int ai = 0; ai < 2; ++ai) {
            float rs[4];
#pragma unroll
            for (int m = 0; m < 4; ++m) rs[m] = rsqrtf(rss[row0 + ai * 128 + m * 16] * (1.0f / D) + EPS);
            const int blk = u.pm * 4 + ai * 2 + wr;
            unsigned pk[4][4];
#pragma unroll
            for (int n = 0; n < 2; ++n) {
                const f32x4 w0 = *(const f32x4*)(cw + c0 + 4 * n), w1 = *(const f32x4*)(cw + FF + c0 + 4 * n), w2 = *(const f32x4*)(cw + 2 * FF + c0 + 4 * n), bb = *(const f32x4*)(cbias + c0 + 4 * n);
#pragma unroll
                for (int jp = 0; jp < 2; ++jp) {
                    const f32x2 w0p = {w0[2 * jp], w0[2 * jp + 1]}, w1p = {w1[2 * jp], w1[2 * jp + 1]}, w2p = {w2[2 * jp], w2[2 * jp + 1]}, bbp = {bb[2 * jp], bb[2 * jp + 1]};
                    f32x2 gm[4], r1[4], r2[4];
#pragma unroll
                    for (int m = 0; m < 4; ++m) {
                        gm[m] = (f32x2){acc[ai][0][m][n][2 * jp], acc[ai][0][m][n][2 * jp + 1]} * rs[m];
                        r1[m].x = __int_as_float(__builtin_amdgcn_update_dpp(0, __float_as_int(gm[m].x), 0x121, 0xF, 0xF, false));
                        r1[m].y = __int_as_float(__builtin_amdgcn_update_dpp(0, __float_as_int(gm[m].y), 0x121, 0xF, 0xF, false));
                        r2[m].x = __int_as_float(__builtin_amdgcn_update_dpp(0, __float_as_int(gm[m].x), 0x122, 0xF, 0xF, false));
                        r2[m].y = __int_as_float(__builtin_amdgcn_update_dpp(0, __float_as_int(gm[m].y), 0x122, 0xF, 0xF, false));
                    }
#pragma unroll
                    for (int m = 0; m < 4; ++m) {
                        const f32x2 q1 = m >= 1 ? r1[m >= 1 ? m - 1 : 0] : (f32x2){0.f, 0.f}, q2 = m >= 1 ? r2[m >= 1 ? m - 1 : 0] : (f32x2){0.f, 0.f};
                        f32x2 p1, p2;
                        p1.x = (fr >= 1) ? r1[m].x : q1.x; p1.y = (fr >= 1) ? r1[m].y : q1.y;
                        p2.x = (fr >= 2) ? r2[m].x : q2.x; p2.y = (fr >= 2) ? r2[m].y : q2.y;
                        const f32x2 a = w2p * gm[m] + (w1p * p1 + (w0p * p2 + bbp));
                        const f32x2 na = a * (-1.4426950408889634f);
                        f32x2 den; den.x = __builtin_amdgcn_exp2f(na.x); den.y = __builtin_amdgcn_exp2f(na.y);
                        den = den + 1.0f;
                        f32x2 rc; rc.x = __builtin_amdgcn_rcpf(den.x); rc.y = __builtin_amdgcn_rcpf(den.y);
                        const f32x2 up = (f32x2){acc[ai][1][m][n][2 * jp], acc[ai][1][m][n][2 * jp + 1]} * rs[m];
                        const f32x2 ov = (a * rc) * up;
                        pk[m][2 * n + jp] = cvt_pk_bf16(ov.x, ov.y);
                    }
                }
            }
#pragma unroll
            for (int m = 0; m < 4; ++m) {
                const size_t row = (size_t)(row0 + ai * 128 + m * 16);
                if (!(m == 0 && fr < 2)) { u32x4 w; w.x = pk[m][0]; w.y = pk[m][1]; w.z = pk[m][2]; w.w = pk[m][3]; *(u32x4*)(act + row * FF + c0) = w; }
            }
            if (fr < 2) {
                const size_t o = ((size_t)blk * 2 + fr) * FF + c0;
                *(f32x4*)(gf + o) = acc[ai][0][0][0] * rs[0]; *(f32x4*)(gf + o + 4) = acc[ai][0][0][1] * rs[0];
                *(f32x4*)(uf + o) = acc[ai][1][0][0] * rs[0]; *(f32x4*)(uf + o + 4) = acc[ai][1][0][1] * rs[0];
            }
            if (fr >= 14) {
                const size_t o = ((size_t)blk * 2 + (fr - 14)) * FF + c0;
                *(f32x4*)(gl + o) = acc[ai][0][3][0] * rs[3]; *(f32x4*)(gl + o + 4) = acc[ai][0][3][1] * rs[3];
            }
        }
    }
};
}

__device__ __forceinline__ void transpose_tile(const float* __restrict__ src, int K, int N, bf16_t* __restrict__ dst, const float* __restrict__ scale, int k0, int n0, int rowmode, LAS float* tl) {
    const int tid = threadIdx.x;
    const int r = tid >> 6, c4 = (tid & 63) * 4;
    f32x4 v[8];
#pragma unroll
    for (int i = 0; i < 8; ++i) v[i] = __builtin_nontemporal_load((const f32x4*)(src + (size_t)(k0 + r + 8 * i) * N + n0 + c4));
#pragma unroll
    for (int i = 0; i < 8; ++i) {
        const int k = r + 8 * i;
        const float s = scale ? scale[k0 + k] : 1.0f;
        tl[k * 257 + c4 + 0] = v[i][0] * s; tl[k * 257 + c4 + 1] = v[i][1] * s; tl[k * 257 + c4 + 2] = v[i][2] * s; tl[k * 257 + c4 + 3] = v[i][3] * s;
    }
    __syncthreads();
    const int kg = (tid & 7) * 8;
#pragma unroll
    for (int q = 0; q < 4; ++q) {
        const int n = (tid >> 3) + 64 * q;
        float f[8];
#pragma unroll
        for (int j = 0; j < 8; ++j) f[j] = tl[(kg + j) * 257 + n];
        const int c = n0 + n;
        const int drow = rowmode == 0 ? c : (256 * (c >> 7) + (c & 127) + (rowmode == 2 ? 128 : 0));
        u32x4 w; w.x = cvt_pk_bf16(f[0], f[1]); w.y = cvt_pk_bf16(f[2], f[3]); w.z = cvt_pk_bf16(f[4], f[5]); w.w = cvt_pk_bf16(f[6], f[7]);
        *(u32x4*)(dst + (size_t)drow * K + k0 + kg) = w;
    }
    __syncthreads();
}

__device__ __forceinline__ void convert_tile(const float* __restrict__ src, int N, bf16_t* __restrict__ dst, const float* __restrict__ scale, int k0, int n0) {
    const int tid = threadIdx.x, r = tid >> 6, c4 = (tid & 63) * 4;
    f32x4 v[8];
#pragma unroll
    for (int i = 0; i < 8; ++i) v[i] = __builtin_nontemporal_load((const f32x4*)(src + (size_t)(k0 + r + 8 * i) * N + n0 + c4));
#pragma unroll
    for (int i = 0; i < 8; ++i) {
        const int k = k0 + r + 8 * i;
        const float sc = scale[k];
        u32x2 o; o.x = cvt_pk_bf16(v[i][0] * sc, v[i][1] * sc); o.y = cvt_pk_bf16(v[i][2] * sc, v[i][3] * sc);
        *(u32x2*)(dst + (size_t)k * N + n0 + c4) = o;
    }
}

__device__ __forceinline__ void rmsnorm_row_bf16(const float* __restrict__ src, const float* __restrict__ w, bf16_t* __restrict__ dst, int lane) {
    f32x4 v[8]; float ss = 0.f;
#pragma unroll
    for (int i = 0; i < 8; ++i) { v[i] = __builtin_nontemporal_load((const f32x4*)(src + i * 256 + lane * 4)); ss += v[i][0] * v[i][0] + v[i][1] * v[i][1] + v[i][2] * v[i][2] + v[i][3] * v[i][3]; }
    ss = wave_sum(ss);
    const float rstd = rsqrtf(ss * (1.0f / D) + EPS);
#pragma unroll
    for (int i = 0; i < 8; ++i) {
        const f32x4 g = *(const f32x4*)(w + i * 256 + lane * 4);
        u32x2 o; o.x = cvt_pk_bf16(v[i][0] * rstd * g[0], v[i][1] * rstd * g[1]); o.y = cvt_pk_bf16(v[i][2] * rstd * g[2], v[i][3] * rstd * g[3]);
        *(u32x2*)(dst + i * 256 + lane * 4) = o;
    }
}

__device__ void phase_prep(const Params& p, LAS unsigned char* lds) {
    const int tid = threadIdx.x, lane = tid & 63, w = tid >> 6;
    unsigned char* ws = p.ws;
    for (int t = blockIdx.x; t < 896 + 5 * 256; t += gridDim.x) {
        if (t < 896) { const int tk = t / 28, tn = t % 28; transpose_tile(p.w_in, D, INC, (bf16_t*)(ws + WS_WIN), nullptr, tk * 64, tn * 256, 0, (LAS float*)lds); }
        else { const int q = (t - 896) >> 8, r = (t - 896) & 255, tk = r >> 3, tn = r & 7;
            const float* src = q == 0 ? p.w_out : q == 1 ? p.wq : q == 2 ? p.wk : q == 3 ? p.wv : p.wo;
            const size_t off = q == 0 ? WS_WOUT : q == 1 ? WS_WQ : q == 2 ? WS_WK : q == 3 ? WS_WV : WS_WO;
            if (q == 1) convert_tile(src, D, (bf16_t*)(ws + off), p.norm2_w, tk * 64, tn * 256);
            else transpose_tile(src, D, D, (bf16_t*)(ws + off), nullptr, tk * 64, tn * 256, 0, (LAS float*)lds); }
    }
    for (int r = blockIdx.x * 8 + w; r < T + 1024; r += gridDim.x * 8) {
        if (r < T) rmsnorm_row_bf16(p.x + (size_t)r * D, p.norm1_w, (bf16_t*)(ws + WS_H) + (size_t)r * D, lane);
        else rmsnorm_row_bf16(p.mem + (size_t)(r - T) * D, p.mem_norm_w, (bf16_t*)(ws + WS_MEMN) + (size_t)(r - T) * D, lane);
    }
    for (int i = blockIdx.x * 512 + tid; i < 2 * T; i += gridDim.x * 512) ((float*)(ws + WS_RSS2))[i] = 0.f;
    for (int i = blockIdx.x * 512 + tid; i < 1024; i += gridDim.x * 512) { const float a0 = p.hgrn_lb[i], a1 = p.hgrn_lb[1024 + i]; ((float*)(ws + WS_LB))[i] = 1.0f / (1.0f + __expf(a1 - a0)); }
}

__device__ void phase_ffn_weights(const Params& p, LAS unsigned char* lds) {
    unsigned char* ws = p.ws;
    for (int t = blockIdx.x; t < 3 * 704; t += gridDim.x) {
        const int q = t / 704, r = t % 704;
        if (q < 2) { const int tk = r / 22, tn = r % 22; transpose_tile(q == 0 ? p.w_gate : p.w_up, D, FF, (bf16_t*)(ws + WS_WGU), p.norm3_w, tk * 64, tn * 256, 1 + q, (LAS float*)lds); }
        else { const int tk = r >> 3, tn = r & 7; transpose_tile(p.w_down, FF, D, (bf16_t*)(ws + WS_WDN), nullptr, tk * 64, tn * 256, 0, (LAS float*)lds); }
    }
}

#define LDS_BARRIER() do { asm volatile("s_waitcnt lgkmcnt(0)" ::: "memory"); __builtin_amdgcn_s_barrier(); asm volatile("" ::: "memory"); } while (0)
__device__ __forceinline__ int hgrn_item_of(int slot, bool deal) {
    if (!deal) { const int item = blockIdx.x + slot * gridDim.x; return item < 4096 ? item : -1; }
    const int c = blockIdx.x;
    if (c < 64) return slot < 3 ? c + 256 * slot : -1;
    if (slot < 16) return c + 256 * slot;
    if (slot >= 21) return -1;
    const int r = (slot - 16) * 192 + (c - 64);
    return r < 832 ? (3 + (r >> 6)) * 256 + (r & 63) : -1;
}

__device__ void phase_hgrn_local(const Params& p, LAS unsigned char* lds) {
    const int tid = threadIdx.x, lane = tid & 63, w = tid >> 6, fr = lane & 15, fq = lane >> 4;
    LAS bf16_t* Ak = (LAS bf16_t*)(lds);
    LAS bf16_t* Vt = (LAS bf16_t*)(lds + 18432);
    LAS float* tots = (LAS float*)(lds + 36864);
    const float* logf = (const float*)(p.ws + WS_LOGF);
    const bf16_t* proj = (const bf16_t*)(p.ws + WS_B0);
    bf16_t* us = (bf16_t*)(p.ws + WS_US);
    float* dec = (float*)(p.ws + WS_DEC);
    const bool deal = (gridDim.x == 256);
    const int kp = lane, sg = w;
    f32x2 c[8]; unsigned vv[8];
#define HL_LOAD(ITEM) do { const int _it = (ITEM); const int _bh = _it >> 7, _n = _it & 127, _b = _bh >> 3, _h = _bh & 7; const size_t _t0 = (size_t)_b * SEQ + (size_t)_n * 64; \
        _Pragma("unroll") for (int i = 0; i < 8; ++i) { c[i] = *(const f32x2*)(logf + (_t0 + 8 * sg + i) * 1024 + _h * 128 + 2 * kp); vv[i] = *(const unsigned*)(proj + (_t0 + 8 * sg + i) * PJ + 1024 + _h * 128 + 2 * kp); } } while (0)
    int item = hgrn_item_of(0, deal);
    if (item >= 0) HL_LOAD(item);
    for (int slot = 0; item >= 0; ++slot) {
        const int nitem = hgrn_item_of(slot + 1, deal);
        f32x2 kk[8];
#pragma unroll
        for (int i = 0; i < 8; ++i) { kk[i].x = 1.0f - __expf(c[i].x); kk[i].y = 1.0f - __expf(c[i].y); }
#pragma unroll
        for (int i = 1; i < 8; ++i) c[i] += c[i - 1];
        *(LAS f32x2*)(tots + sg * 128 + 2 * kp) = c[7];
        LDS_BARRIER();
        f32x2 off = {0.f, 0.f}, tot = {0.f, 0.f};
#pragma unroll
        for (int g = 0; g < 8; ++g) { const f32x2 tv = *(const LAS f32x2*)(tots + g * 128 + 2 * kp); if (g < sg) off += tv; tot += tv; }
        float e0[8], e1[8];
#pragma unroll
        for (int i = 0; i < 8; ++i) { e0[i] = kk[i].x * __expf(tot.x - off.x - c[i].x); e1[i] = kk[i].y * __expf(tot.y - off.y - c[i].y); }
        u32x4 a0, a1, v0, v1;
        a0.x = cvt_pk_bf16(e0[0], e0[1]); a0.y = cvt_pk_bf16(e0[2], e0[3]); a0.z = cvt_pk_bf16(e0[4], e0[5]); a0.w = cvt_pk_bf16(e0[6], e0[7]);
        a1.x = cvt_pk_bf16(e1[0], e1[1]); a1.y = cvt_pk_bf16(e1[2], e1[3]); a1.z = cvt_pk_bf16(e1[4], e1[5]); a1.w = cvt_pk_bf16(e1[6], e1[7]);
        v0.x = (vv[0] & 0xffffu) | (vv[1] << 16); v0.y = (vv[2] & 0xffffu) | (vv[3] << 16); v0.z = (vv[4] & 0xffffu) | (vv[5] << 16); v0.w = (vv[6] & 0xffffu) | (vv[7] << 16);
        v1.x = (vv[0] >> 16) | (vv[1] & 0xffff0000u); v1.y = (vv[2] >> 16) | (vv[3] & 0xffff0000u); v1.z = (vv[4] >> 16) | (vv[5] & 0xffff0000u); v1.w = (vv[6] >> 16) | (vv[7] & 0xffff0000u);
        *(LAS u32x4*)(Ak + (2 * kp) * 72 + 8 * sg) = a0; *(LAS u32x4*)(Ak + (2 * kp + 1) * 72 + 8 * sg) = a1;
        *(LAS u32x4*)(Vt + (2 * kp) * 72 + 8 * sg) = v0; *(LAS u32x4*)(Vt + (2 * kp + 1) * 72 + 8 * sg) = v1;
        if (sg == 0) { f32x2 d; d.x = __expf(tot.x); d.y = __expf(tot.y); *(f32x2*)(dec + (size_t)item * 128 + 2 * kp) = d; }
        if (nitem >= 0) HL_LOAD(nitem);
        LDS_BARRIER();
        f32x4 acc[8];
#pragma unroll
        for (int kt = 0; kt < 8; ++kt) acc[kt] = (f32x4){0.f, 0.f, 0.f, 0.f};
#pragma unroll
        for (int ks = 0; ks < 2; ++ks) {
            const bf16x8 bq = *(const LAS bf16x8*)(Vt + (16 * w + fr) * 72 + 32 * ks + 8 * fq);
#pragma unroll
            for (int kt = 0; kt < 8; ++kt) { const bf16x8 a = *(const LAS bf16x8*)(Ak + (16 * kt + fr) * 72 + 32 * ks + 8 * fq); acc[kt] = __builtin_amdgcn_mfma_f32_16x16x32_bf16(a, bq, acc[kt], 0, 0, 0); }
        }
        bf16_t* dst = us + (size_t)item * 16384 + (16 * w + fr) * 128 + 4 * fq;
#pragma unroll
        for (int kt = 0; kt < 8; ++kt) { u32x2 o; o.x = cvt_pk_bf16_c(acc[kt][0], acc[kt][1]); o.y = cvt_pk_bf16_c(acc[kt][2], acc[kt][3]); *(u32x2*)(dst + 16 * kt) = o; }
        LDS_BARRIER();
        item = nitem;
    }
#undef HL_LOAD
}

__device__ void phase_hgrn_scan(const Params& p) {
    const bf16_t* us = (const bf16_t*)(p.ws + WS_US);
    bf16_t* sb = (bf16_t*)p.out;
    const float* dec = (const float*)(p.ws + WS_DEC);
    for (int idx = blockIdx.x * 512 + threadIdx.x; idx < 32 * 4096; idx += gridDim.x * 512) {
        const int bh = idx >> 12, e = (idx & 4095) * 4, k = e & 127;
        const bf16_t* base = us + (size_t)bh * 128 * 16384 + e;
        bf16_t* obase = sb + (size_t)bh * 128 * 16384 + e;
        const float* dbase = dec + (size_t)bh * 128 * 128 + k;
        f32x4 s = {0.f, 0.f, 0.f, 0.f};
        for (int n0 = 0; n0 < 128; n0 += 8) {
            u32x2 uu[8]; f32x4 dd[8];
#pragma unroll
            for (int i = 0; i < 8; ++i) { uu[i] = *(const u32x2*)(base + (size_t)(n0 + i) * 16384); dd[i] = *(const f32x4*)(dbase + (n0 + i) * 128); }
#pragma unroll
            for (int i = 0; i < 8; ++i) {
                u32x2 o; o.x = cvt_pk_bf16(s[0], s[1]); o.y = cvt_pk_bf16(s[2], s[3]);
                *(u32x2*)(obase + (size_t)(n0 + i) * 16384) = o;
                const f32x4 u4 = {bf_lo(uu[i].x), bf_hi(uu[i].x), bf_lo(uu[i].y), bf_hi(uu[i].y)};
                s = s * dd[i] + u4;
            }
        }
    }
}

__device__ void phase_hgrn_out(const Params& p, LAS unsigned char* lds) {
    const int tid = threadIdx.x, lane = tid & 63, w = tid >> 6, fr = lane & 15, fq = lane >> 4;
    LAS bf16_t* Qe = (LAS bf16_t*)(lds);
    LAS bf16_t* Ke = (LAS bf16_t*)(lds + 17408);
    LAS bf16_t* St = (LAS bf16_t*)(lds + 34816);
    LAS bf16_t* Vt = (LAS bf16_t*)(lds + 69632);
    LAS bf16_t* Pm = (LAS bf16_t*)(lds + 88064);
    LAS float* tots = (LAS float*)(lds + 97280);
    LAS float* ssq = (LAS float*)(lds + 101376);
    const float* logf = (const float*)(p.ws + WS_LOGF);
    const bf16_t* proj = (const bf16_t*)(p.ws + WS_B0);
    const bf16_t* us = (const bf16_t*)p.out;
    bf16_t* mix = (bf16_t*)(p.ws + WS_H);
    const int kp = lane, sg = w;
    f32x2 c[8]; unsigned vv[8], qv[8]; u32x2 sv[8];
#define HG_LOAD_PRE(ITEM) do { const int _it = (ITEM); const int _bh = _it >> 7, _n = _it & 127, _b = _bh >> 3, _h = _bh & 7; const size_t _t0 = (size_t)_b * SEQ + (size_t)_n * 64; \
        _Pragma("unroll") for (int i = 0; i < 8; ++i) { const size_t t = _t0 + 8 * sg + i; \
            c[i] = *(const f32x2*)(logf + t * 1024 + _h * 128 + 2 * kp); qv[i] = *(const unsigned*)(proj + t * PJ + _h * 128 + 2 * kp); vv[i] = *(const unsigned*)(proj + t * PJ + 1024 + _h * 128 + 2 * kp); } \
        _Pragma("unroll") for (int i = 0; i < 8; ++i) { const int idx = tid + 512 * i; sv[i] = *(const u32x2*)(us + (size_t)_it * 16384 + (idx >> 5) * 128 + (idx & 31) * 4); } } while (0)
    if ((int)blockIdx.x < 4096) HG_LOAD_PRE(blockIdx.x);
    for (int item = blockIdx.x; item < 4096; item += gridDim.x) {
        const int bh = item >> 7, n = item & 127, b = bh >> 3, h = bh & 7;
        const size_t t0 = (size_t)b * SEQ + (size_t)n * 64;
        f32x2 kk[8];
#pragma unroll
        for (int i = 0; i < 8; ++i) { kk[i].x = 1.0f - __expf(c[i].x); kk[i].y = 1.0f - __expf(c[i].y); }
#pragma unroll
        for (int i = 1; i < 8; ++i) c[i] += c[i - 1];
        *(LAS f32x2*)(tots + sg * 128 + 2 * kp) = c[7];
        LDS_BARRIER();
        f32x2 off = {0.f, 0.f}, tot = {0.f, 0.f};
#pragma unroll
        for (int g = 0; g < 8; ++g) { const f32x2 tv = *(const LAS f32x2*)(tots + g * 128 + 2 * kp); if (g < sg) off += tv; tot += tv; }
        const f32x2 ref = tot * 0.5f;
#pragma unroll
        for (int i = 0; i < 8; ++i) {
            const float bx = off.x + c[i].x - ref.x, by = off.y + c[i].y - ref.y;
            const int t = 8 * sg + i;
            *(LAS unsigned*)(Qe + t * 136 + 2 * kp) = cvt_pk_bf16(bf_lo(qv[i]) * __expf(bx), bf_hi(qv[i]) * __expf(by));
            *(LAS unsigned*)(Ke + t * 136 + 2 * kp) = cvt_pk_bf16(kk[i].x * __expf(-bx), kk[i].y * __expf(-by));
        }
        {
            u32x4 v0, v1;
            v0.x = (vv[0] & 0xffffu) | (vv[1] << 16); v0.y = (vv[2] & 0xffffu) | (vv[3] << 16); v0.z = (vv[4] & 0xffffu) | (vv[5] << 16); v0.w = (vv[6] & 0xffffu) | (vv[7] << 16);
            v1.x = (vv[0] >> 16) | (vv[1] & 0xffff0000u); v1.y = (vv[2] >> 16) | (vv[3] & 0xffff0000u); v1.z = (vv[4] >> 16) | (vv[5] & 0xffff0000u); v1.w = (vv[6] >> 16) | (vv[7] & 0xffff0000u);
            *(LAS u32x4*)(Vt + (2 * kp) * 72 + 8 * sg) = v0; *(LAS u32x4*)(Vt + (2 * kp + 1) * 72 + 8 * sg) = v1;
        }
        {
            const int k4 = (tid & 31) * 4;
            f32x4 tt = {0.f, 0.f, 0.f, 0.f};
#pragma unroll
            for (int g = 0; g < 8; ++g) tt += *(const LAS f32x4*)(tots + g * 128 + k4);
            const f32x4 er = {__expf(0.5f * tt[0]), __expf(0.5f * tt[1]), __expf(0.5f * tt[2]), __expf(0.5f * tt[3])};
#pragma unroll
            for (int i = 0; i < 8; ++i) {
                const int v = (tid >> 5) + 16 * i;
                u32x2 o; o.x = cvt_pk_bf16(bf_lo(sv[i].x) * er[0], bf_hi(sv[i].x) * er[1]); o.y = cvt_pk_bf16(bf_lo(sv[i].y) * er[2], bf_hi(sv[i].y) * er[3]);
                *(LAS u32x2*)(St + v * 136 + k4) = o;
            }
        }
        const int tb = w >> 1, hf = w & 1, tl = 16 * tb + fr;
        u32x2 gg[4];
#pragma unroll
        for (int i = 0; i < 4; ++i) gg[i] = *(const u32x2*)(proj + (t0 + tl) * PJ + 2048 + h * 128 + 16 * (4 * hf + i) + 4 * fq);
        const int cc_ = h * 128 + (tid & 31) * 4, tr = tid >> 5;
        u32x2 za[6], zb[6], cbv[4];
#pragma unroll
        for (int r = 0; r < 6; ++r) {
            const int tt = 4 * tr + r - 2;
            if (tt < 0 && n == 0) { za[r] = (u32x2){0u, 0u}; zb[r] = (u32x2){0u, 0u}; }
            else { const bf16_t* rp = proj + (size_t)((long)t0 + tt) * PJ; za[r] = *(const u32x2*)(rp + 4096 + cc_); zb[r] = *(const u32x2*)(rp + 5120 + cc_); }
        }
#pragma unroll
        for (int i = 0; i < 4; ++i) cbv[i] = *(const u32x2*)(proj + (t0 + 4 * tr + i) * PJ + 3072 + cc_);
        if (item + (int)gridDim.x < 4096) HG_LOAD_PRE(item + (int)gridDim.x);
        LDS_BARRIER();
#pragma unroll
        for (int s2 = 0; s2 < 2; ++s2) {
            const int st = 2 * hf + s2;
            f32x4 a4 = {0.f, 0.f, 0.f, 0.f};
            if (st <= tb) {
#pragma unroll
                for (int ks = 0; ks < 4; ++ks) {
                    const bf16x8 a = *(const LAS bf16x8*)(Ke + (16 * st + fr) * 136 + 32 * ks + 8 * fq);
                    const bf16x8 bq = *(const LAS bf16x8*)(Qe + tl * 136 + 32 * ks + 8 * fq);
                    a4 = __builtin_amdgcn_mfma_f32_16x16x32_bf16(a, bq, a4, 0, 0, 0);
                }
            }
            const int s0 = 16 * st + 4 * fq;
            u32x2 o; o.x = cvt_pk_bf16(s0 + 0 <= tl ? a4[0] : 0.f, s0 + 1 <= tl ? a4[1] : 0.f); o.y = cvt_pk_bf16(s0 + 2 <= tl ? a4[2] : 0.f, s0 + 3 <= tl ? a4[3] : 0.f);
            *(LAS u32x2*)(Pm + tl * 72 + s0) = o;
        }
        LDS_BARRIER();
        f32x4 ao[4];
#pragma unroll
        for (int i = 0; i < 4; ++i) ao[i] = (f32x4){0.f, 0.f, 0.f, 0.f};
#pragma unroll
        for (int ks = 0; ks < 4; ++ks) {
            const bf16x8 bq = *(const LAS bf16x8*)(Qe + tl * 136 + 32 * ks + 8 * fq);
#pragma unroll
            for (int i = 0; i < 4; ++i) { const bf16x8 a = *(const LAS bf16x8*)(St + (16 * (4 * hf + i) + fr) * 136 + 32 * ks + 8 * fq); ao[i] = __builtin_amdgcn_mfma_f32_16x16x32_bf16(a, bq, ao[i], 0, 0, 0); }
        }
#pragma unroll
        for (int ks = 0; ks < 2; ++ks) {
            const bf16x8 bq = *(const LAS bf16x8*)(Pm + tl * 72 + 32 * ks + 8 * fq);
#pragma unroll
            for (int i = 0; i < 4; ++i) { const bf16x8 a = *(const LAS bf16x8*)(Vt + (16 * (4 * hf + i) + fr) * 72 + 32 * ks + 8 * fq); ao[i] = __builtin_amdgcn_mfma_f32_16x16x32_bf16(a, bq, ao[i], 0, 0, 0); }
        }
        float ss = 0.f;
#pragma unroll
        for (int i = 0; i < 4; ++i)
#pragma unroll
            for (int j = 0; j < 4; ++j) ss += ao[i][j] * ao[i][j];
        ss += __shfl_xor(ss, 16); ss += __shfl_xor(ss, 32);
        if (fq == 0) ssq[tl * 2 + hf] = ss;
        LDS_BARRIER();
        const float rstd = rsqrtf((ssq[tl * 2] + ssq[tl * 2 + 1]) * (1.0f / 128.0f) + EPS);
#pragma unroll
        for (int i = 0; i < 4; ++i) {
            const int v0 = 16 * (4 * hf + i) + 4 * fq;
            const f32x4 nw = *(const f32x4*)(p.hgrn_norm_w + v0);
            u32x2 o;
            o.x = cvt_pk_bf16(ao[i][0] * rstd * nw[0] * silu_f(bf_lo(gg[i].x)), ao[i][1] * rstd * nw[1] * silu_f(bf_hi(gg[i].x)));
            o.y = cvt_pk_bf16(ao[i][2] * rstd * nw[2] * silu_f(bf_lo(gg[i].y)), ao[i][3] * rstd * nw[3] * silu_f(bf_hi(gg[i].y)));
            *(u32x2*)(mix + (t0 + tl) * D + h * 128 + v0) = o;
        }
        {
            const f32x4 w0 = *(const f32x4*)(p.sconv_w + cc_), w1 = *(const f32x4*)(p.sconv_w + 1024 + cc_), w2 = *(const f32x4*)(p.sconv_w + 2048 + cc_);
            f32x4 z[6];
#pragma unroll
            for (int r = 0; r < 6; ++r) z[r] = (f32x4){bf_lo(za[r].x) * bf_lo(zb[r].x), bf_hi(za[r].x) * bf_hi(zb[r].x), bf_lo(za[r].y) * bf_lo(zb[r].y), bf_hi(za[r].y) * bf_hi(zb[r].y)};
#pragma unroll
            for (int i = 0; i < 4; ++i) {
                const size_t t = t0 + 4 * tr + i;
                const f32x4 y = w0 * z[i] + w1 * z[i + 1] + w2 * z[i + 2];
                u32x2 o; o.x = cvt_pk_bf16(bf_lo(cbv[i].x) * y[0], bf_hi(cbv[i].x) * y[1]); o.y = cvt_pk_bf16(bf_lo(cbv[i].y) * y[2], bf_hi(cbv[i].y) * y[3]);
                *(u32x2*)(mix + t * D + 1024 + cc_) = o;
            }
        }
        LDS_BARRIER();
    }
#undef HG_LOAD_PRE
}

__device__ void phase_fixup(const Params& p) {
    const float* gf = (const float*)(p.ws + WS_GF); const float* uf = (const float*)(p.ws + WS_UF); const float* gl = (const float*)(p.ws + WS_GL);
    bf16_t* act = (bf16_t*)(p.ws + WS_ACT);
    const int per = FF / 4;
    for (int idx = blockIdx.x * 512 + threadIdx.x; idx < 512 * 2 * per; idx += gridDim.x * 512) {
        const int c = (idx % per) * 4, br = idx / per, r = br & 1, blk = br >> 1;
        const bool first = (blk & 127) == 0;
        const f32x4 zero = {0.f, 0.f, 0.f, 0.f};
        const f32x4 g0 = *(const f32x4*)(gf + ((size_t)blk * 2 + r) * FF + c);
        f32x4 g1, g2;
        if (r == 0) { g1 = first ? zero : *(const f32x4*)(gl + ((size_t)(blk - 1) * 2 + 1) * FF + c); g2 = first ? zero : *(const f32x4*)(gl + ((size_t)(blk - 1) * 2) * FF + c); }
        else { g1 = *(const f32x4*)(gf + ((size_t)blk * 2) * FF + c); g2 = first ? zero : *(const f32x4*)(gl + ((size_t)(blk - 1) * 2 + 1) * FF + c); }
        const f32x4 uu = *(const f32x4*)(uf + ((size_t)blk * 2 + r) * FF + c);
        const f32x4 w0 = *(const f32x4*)(p.ffn_conv_w + c), w1 = *(const f32x4*)(p.ffn_conv_w + FF + c), w2 = *(const f32x4*)(p.ffn_conv_w + 2 * FF + c), bb = *(const f32x4*)(p.ffn_conv_b + c);
        const f32x4 a = w2 * g0 + w1 * g1 + w0 * g2 + bb;
        u32x2 o; o.x = cvt_pk_bf16(silu_f(a[0]) * uu[0], silu_f(a[1]) * uu[1]); o.y = cvt_pk_bf16(silu_f(a[2]) * uu[2], silu_f(a[3]) * uu[3]);
        *(u32x2*)(act + ((size_t)blk * 64 + r) * FF + c) = o;
    }
}

__device__ void phase_final(const Params& p) {
    const int lane = threadIdx.x & 63, w = threadIdx.x >> 6;
    const bf16_t* x3 = (const bf16_t*)(p.ws + WS_B0);
    for (int r = blockIdx.x * 8 + w; r < T; r += gridDim.x * 8) {
        const bf16_t* src = x3 + (size_t)r * D;
        float* row = p.out + (size_t)r * D;
        u32x4 v[4]; float ss = 0.f;
#pragma unroll
        for (int i = 0; i < 4; ++i) {
            v[i] = *(const u32x4*)(src + i * 512 + lane * 8);
            const float a0 = bf_lo(v[i].x), a1 = bf_hi(v[i].x), a2 = bf_lo(v[i].y), a3 = bf_hi(v[i].y), a4 = bf_lo(v[i].z), a5 = bf_hi(v[i].z), a6 = bf_lo(v[i].w), a7 = bf_hi(v[i].w);
            ss += a0 * a0 + a1 * a1 + a2 * a2 + a3 * a3 + a4 * a4 + a5 * a5 + a6 * a6 + a7 * a7;
        }
        ss = wave_sum(ss);
        const float rstd = rsqrtf(ss * (1.0f / D) + EPS);
#pragma unroll
        for (int i = 0; i < 4; ++i) {
            const f32x4 g0 = *(const f32x4*)(p.final_norm_w + i * 512 + lane * 8), g1 = *(const f32x4*)(p.final_norm_w + i * 512 + lane * 8 + 4);
            f32x4 o0 = {bf_lo(v[i].x), bf_hi(v[i].x), bf_lo(v[i].y), bf_hi(v[i].y)}, o1 = {bf_lo(v[i].z), bf_hi(v[i].z), bf_lo(v[i].w), bf_hi(v[i].w)};
            __builtin_nontemporal_store(o0 * rstd * g0, (f32x4*)(row + i * 512 + lane * 8)); __builtin_nontemporal_store(o1 * rstd * g1, (f32x4*)(row + i * 512 + lane * 8 + 4));
        }
    }
}

#define XB_TMO      128
#define XB_XCNT(j)  (256  + 64 * (j))
#define XB_XSUB(j)  (1280 + 64 * (j))
#define XB_XGEN(j)  (2304 + 64 * (j))
#define XB_TOP      3328
#define XB_TOPGEN   3392
#define XCD_BAR_WORDS 3456
#define XB_SPIN_CAP (1u << 21)
__device__ __forceinline__ unsigned xb_ld(unsigned* p)              { return __hip_atomic_load(p, __ATOMIC_RELAXED, __HIP_MEMORY_SCOPE_AGENT); }
__device__ __forceinline__ unsigned xb_add(unsigned* p, unsigned v) { return __hip_atomic_fetch_add(p, v, __ATOMIC_RELAXED, __HIP_MEMORY_SCOPE_AGENT); }
__device__ __forceinline__ unsigned xb_xcc_id() { return (unsigned)__builtin_amdgcn_s_getreg((3 << 11) | 20) & 0xFu; }
#define XB_SPIN(cond, bar) do { unsigned _sp = 0; while (cond) { __builtin_amdgcn_s_sleep(1); \
    if ((++_sp & 255u) == 0u) { if (xb_ld(&(bar)[XB_TMO])) break; if (_sp > XB_SPIN_CAP) { atomicAdd(&(bar)[XB_TMO], 1u); break; } } } } while (0)
struct XcdBarrier { unsigned* bar; unsigned x; volatile LAS unsigned* st; };
__device__ __forceinline__ XcdBarrier xcd_barrier_post(unsigned* bar, volatile LAS unsigned* st) {
    XcdBarrier b; b.bar = bar; b.x = xb_xcc_id(); b.st = st;
    if (threadIdx.x == 0) (void)xb_add(&bar[XB_XCNT(b.x)], 1u);
    return b;
}
__device__ __forceinline__ void xcd_barrier_complete(unsigned* bar, unsigned x, unsigned& nloc, unsigned& nx) {
    const unsigned G = gridDim.x * gridDim.y * gridDim.z;
    unsigned sum, cnt, mine, sp = 0u;
    for (;;) {
        sum = 0u; cnt = 0u; mine = 0u;
#pragma unroll
        for (unsigned j = 0; j < 16; ++j) { const unsigned c = xb_ld(&bar[XB_XCNT(j)]); sum += c; cnt += (c > 0u) ? 1u : 0u; mine = (j == x) ? c : mine; }
        if (sum == G) break;
        __builtin_amdgcn_s_sleep(1);
        if ((++sp & 255u) == 0u) { if (xb_ld(&bar[XB_TMO])) break; if (sp > XB_SPIN_CAP) { atomicAdd(&bar[XB_TMO], 1u); break; } }
    }
    nloc = mine > 0u ? mine : 1u; nx = cnt > 0u ? cnt : 1u;
}
__device__ __forceinline__ void xcd_barrier(const XcdBarrier& b) {
    asm volatile("s_waitcnt vmcnt(0)" ::: "memory");
    __syncthreads();
    if (threadIdx.x == 0) {
        unsigned* bar = b.bar;
        __builtin_amdgcn_s_waitcnt(0);
        unsigned nloc = b.st[0], nx = b.st[1];
        if (nloc == 0u) { xcd_barrier_complete(bar, b.x, nloc, nx); b.st[0] = nloc; b.st[1] = nx; }
        const unsigned old = xb_add(&bar[XB_XSUB(b.x)], 1u);
        const unsigned gen = old / nloc;
        if (old + 1u == (gen + 1u) * nloc) {
            __builtin_amdgcn_fence(__ATOMIC_RELEASE, "agent");
            asm volatile("s_waitcnt vmcnt(0)" ::: "memory");
            const unsigned og = xb_add(&bar[XB_TOP], 1u);
            const unsigned tg = og / nx;
            if (og + 1u == (tg + 1u) * nx) xb_add(&bar[XB_TOPGEN], 1u);
            else XB_SPIN(xb_ld(&bar[XB_TOPGEN]) == tg, bar);
            __builtin_amdgcn_fence(__ATOMIC_ACQUIRE, "agent");
            xb_add(&bar[XB_XGEN(b.x)], 1u);
            asm volatile("s_waitcnt vmcnt(0)" ::: "memory");
        } else {
            XB_SPIN(xb_ld(&bar[XB_XGEN(b.x)]) == gen, bar);
            __builtin_amdgcn_fence(__ATOMIC_ACQUIRE, "agent");
            asm volatile("s_waitcnt vmcnt(0)" ::: "memory");
        }
    }
    __syncthreads();
}

__global__ void __launch_bounds__(512) fwd_megakernel(Params p) {
    extern __shared__ __attribute__((aligned(16))) unsigned char smem[];
    LAS unsigned char* lds = (LAS unsigned char*)smem;
    unsigned char* ws = p.ws;
    bf16_t* const H = (bf16_t*)(ws + WS_H); bf16_t* const B0 = (bf16_t*)(ws + WS_B0); bf16_t* const B1 = (bf16_t*)(ws + WS_B1); bf16_t* const B2 = (bf16_t*)(ws + WS_B2);
    float* const rss2 = (float*)(ws + WS_RSS2); float* const rss3 = (float*)(ws + WS_RSS3);
#define RUN(k) (PH_ON(k) && p.ph_lo <= (k) && (k) <= p.ph_hi)
    volatile LAS unsigned* stw = (volatile LAS unsigned*)(lds + STAGE_BYTES + 8192);
    if (threadIdx.x < 4) stw[threadIdx.x] = 0u;
    __syncthreads();
    XcdBarrier xbar; xbar.bar = (unsigned*)(ws + WS_BAR); xbar.x = 0u; xbar.st = stw;
    if (p.ph_lo < p.ph_hi) xbar = xcd_barrier_post((unsigned*)(ws + WS_BAR), stw);
    if (p.ph_hi > 1000) cg::this_grid().sync();
#define SEAM(k) do { if (p.ph_lo <= (k) && (k) < p.ph_hi) xcd_barrier(xbar); } while (0)
    if (RUN(0)) { phase_prep(p, lds); }
    SEAM(0);
    if (RUN(1)) {
        { pg8::Gemm g{H, (const bf16_t*)(ws + WS_WIN), D, D, D}; pg8::Order S; S.init(T / 256, INC / 256, 0, D, D);
          pg8::EpiIn E{B0, (float*)(ws + WS_LOGF), (const float*)(ws + WS_LB)}; pg8::gemm_phase(lds, g, S, E); }
    }
    SEAM(1);
    if (RUN(2)) {
        { pg8::Gemm g{(const bf16_t*)(ws + WS_MEMN), (const bf16_t*)(ws + WS_WK), D, D, D}; pg8::Order S; S.init(4, 16, 0, D, D);
          pg8::EpiB E{(bf16_t*)(ws + WS_KP), 2 * D, nullptr}; pg8::gemm_phase(lds, g, S, E); }
        phase_hgrn_local(p, lds);
    }
    SEAM(2);
    if (RUN(3)) {
        { pg8::Gemm g{(const bf16_t*)(ws + WS_KP), (const bf16_t*)(ws + WS_WQ), 2 * D, D, 512}; pg8::Order S; S.init(16, 8, 3, 2 * D, D);
          pg8::EpiB E{(bf16_t*)(ws + WS_WQK), D, nullptr}; pg8::gemm_phase(lds, g, S, E); }
        { pg8::Gemm g{(const bf16_t*)(ws + WS_WO), (const bf16_t*)(ws + WS_KP), D, 2 * D, 512}; pg8::Order S; S.init(32, 4, 4, D, 2 * D, 128);
          pg8::EpiB E{(bf16_t*)(ws + WS_WVO), 1024, nullptr}; pg8::gemm_phase(lds, g, S, E); }
        phase_hgrn_scan(p);
    }
    SEAM(3);
    if (RUN(4)) { phase_hgrn_out(p, lds); }
    SEAM(4);
    if (RUN(5)) {
        pg8::Gemm g{H, (const bf16_t*)(ws + WS_WOUT), D, D, D}; pg8::Order S; S.init(T / 256, D / 256, 0, D, D);
        pg8::EpiRes<false, false, true, true> E{p.x, nullptr, B0, rss2}; pg8::gemm_phase(lds, g, S, E);
    }
    SEAM(5);
    if (RUN(6)) {
        phase_ffn_weights(p, lds);
        pg8::Gemm g{B0, (const bf16_t*)(ws + WS_WQK), D, D, D}; pg8::Order S; S.init(T / 256, 4, 5, D, D);
        pg8::EpiSm E{B2, (LAS float*)(lds + STAGE_BYTES), rss2}; pg8::gemm_phase(lds, g, S, E);
    }
    SEAM(6);
    if (RUN(7)) {
        pg8::Gemm g{B2, (const bf16_t*)(ws + WS_WVO), 1024, 1024, 1024}; pg8::Order S; S.init(T / 256, D / 256, 6, 1024, 1024);
        pg8::EpiRes<true, false, true, true> E{B0, nullptr, B0, rss3}; pg8::gemm_phase(lds, g, S, E);
    }
    SEAM(7);
    if (RUN(8)) {
        pg8::Gemm g{B0, (const bf16_t*)(ws + WS_WGU), D, D, D}; pg8::Order S; S.init(T / 256, 2 * FF / 256, 0, D, D);
        pg8::EpiGu E{(bf16_t*)(ws + WS_ACT), rss3, p.ffn_conv_w, p.ffn_conv_b, (float*)(ws + WS_GF), (float*)(ws + WS_UF), (float*)(ws + WS_GL)}; pg8::gemm_phase(lds, g, S, E);
    }
    SEAM(8);
    if (RUN(9)) { phase_fixup(p); }
    SEAM(9);
    if (RUN(10)) {
        pg8::Gemm g{(const bf16_t*)(ws + WS_ACT), (const bf16_t*)(ws + WS_WDN), FF, FF, FF}; pg8::Order S; S.init(T / 256, D / 256, 0, FF, FF);
        pg8::EpiRes<true, false, true, false> E{B0, nullptr, B0, nullptr}; pg8::gemm_phase(lds, g, S, E);
    }
    SEAM(10);
    if (RUN(11)) { phase_final(p); }
}

extern "C" void kernel_launch(void* const* d_in, const int* in_sizes, int n_in, void* d_out, int out_size, void* d_ws, size_t ws_size, hipStream_t stream) {
    static int grid = 0;
    if (grid == 0) {
        if (n_in != 21 || ws_size < WS_END) { fprintf(stderr, "kernel_launch: unexpected inputs (%d) or workspace (%zu < %zu)\n", n_in, ws_size, (size_t)WS_END); grid = -1; return; }
        int dev = 0, cus = 0, per_cu = 0;
        hipGetDevice(&dev);
        hipDeviceGetAttribute(&cus, hipDeviceAttributeMultiprocessorCount, dev);
        if (hipFuncSetAttribute((const void*)fwd_megakernel, hipFuncAttributeMaxDynamicSharedMemorySize, LDS_BYTES) != hipSuccess) { fprintf(stderr, "kernel_launch: hipFuncSetAttribute failed\n"); grid = -1; return; }
        if (hipOccupancyMaxActiveBlocksPerMultiprocessor(&per_cu, (const void*)fwd_megakernel, 512, LDS_BYTES) != hipSuccess || per_cu < 1) { (void)hipGetLastError(); per_cu = 1; }
        grid = cus * per_cu;
    }
    if (grid < 0) return;
    Params p{};
    const float** f = (const float**)&p;
    for (int i = 0; i < 21; ++i) f[i] = (const float*)d_in[i];
    p.out = (float*)d_out; p.ws = (unsigned char*)d_ws;
#if MULTI_LAUNCH
    for (int ph = 0; ph < NPHASE; ++ph) {
        p.ph_lo = ph; p.ph_hi = ph;
        hipLaunchKernelGGL(fwd_megakernel, dim3(grid), dim3(512), LDS_BYTES, stream, p);
    }
#else
    p.ph_lo = 0; p.ph_hi = NPHASE - 1;
    if (hipMemsetAsync((char*)d_ws + WS_BAR, 0, XCD_BAR_WORDS * 4, stream) != hipSuccess) { fprintf(stderr, "kernel_launch: hipMemsetAsync failed\n"); return; }
    void* args[] = {&p};
    hipError_t e = hipLaunchCooperativeKernel((const void*)fwd_megakernel, dim3(grid), dim3(512), args, LDS_BYTES, stream);
    if (e != hipSuccess) fprintf(stderr, "cooperative launch failed: %s (grid %d)\n", hipGetErrorString(e), grid);
#endif
}
```

```cpp
#include <hip/hip_runtime.h>
#include <hip/hip_cooperative_groups.h>
#include <cstdio>
namespace cg = cooperative_groups;

#ifndef MULTI_LAUNCH
#define MULTI_LAUNCH 0
#endif

#ifndef ONLY_PHASE
#define ONLY_PHASE -1
#endif
#define PH_ON(k) (ONLY_PHASE < 0 || ONLY_PHASE == (k))

#define LAS __attribute__((address_space(3)))
typedef unsigned short bf16_t;
typedef short bf16x8 __attribute__((ext_vector_type(8)));
typedef float f32x4 __attribute__((ext_vector_type(4)));
typedef float f32x2 __attribute__((ext_vector_type(2)));
typedef unsigned u32x4 __attribute__((ext_vector_type(4)));
typedef unsigned u32x2 __attribute__((ext_vector_type(2)));

constexpr int T = 32768, D = 2048, SEQ = 8192;
constexpr int INC = 7168, PJ = 6144;
constexpr int FF = 5632;
constexpr float EPS = 1e-6f;
constexpr int NPHASE = 12;

constexpr size_t SZ_TD2 = (size_t)T * D * 2;
constexpr size_t WS_WIN = 0;
constexpr size_t WS_WOUT = WS_WIN + (size_t)INC * D * 2;
constexpr size_t WS_WQ = WS_WOUT + (size_t)D * D * 2;
constexpr size_t WS_WK = WS_WQ + (size_t)D * D * 2;
constexpr size_t WS_WV = WS_WK + (size_t)D * D * 2;
constexpr size_t WS_WO = WS_WV + (size_t)D * D * 2;
constexpr size_t WS_H = WS_WO + (size_t)D * D * 2;
constexpr size_t WS_B0 = WS_H + SZ_TD2;
constexpr size_t WS_B1 = WS_B0 + SZ_TD2;
constexpr size_t WS_B2 = WS_B1 + SZ_TD2;
constexpr size_t WS_LOGF = WS_B2 + SZ_TD2;
constexpr size_t WS_US = WS_LOGF + SZ_TD2;
constexpr size_t WS_MEMN = WS_US + (size_t)4096 * 16384 * 4;
constexpr size_t WS_KP = WS_MEMN + (size_t)1024 * D * 2;
constexpr size_t WS_VT = WS_KP + (size_t)1024 * D * 2;
constexpr size_t WS_DEC = WS_VT + (size_t)1024 * D * 2;
constexpr size_t WS_RSS2 = WS_DEC + (size_t)4096 * 128 * 4;
constexpr size_t WS_RSS3 = WS_RSS2 + (size_t)T * 4;
constexpr size_t WS_LB = WS_RSS3 + (size_t)T * 4;
constexpr size_t WS_WQK = WS_LB + 4096;
constexpr size_t WS_WVO = WS_WQK + (size_t)4 * 1024 * D * 2;
constexpr size_t WS_BAR = WS_WVO + (size_t)4 * D * 1024 * 2;
constexpr size_t WS_END = WS_BAR + 16384;
constexpr size_t WS_WGU = WS_US;
constexpr size_t WS_WDN = WS_US + (size_t)2 * FF * D * 2;
constexpr size_t WS_ACT = WS_B1;
constexpr size_t SZ_HALO = (size_t)512 * 2 * FF * 4;
constexpr size_t WS_GF = WS_H, WS_UF = WS_H + SZ_HALO, WS_GL = WS_H + 2 * SZ_HALO;
static_assert(WS_ACT + (size_t)T * FF * 2 <= WS_US, "act overlaps FFN weights");
static_assert(3 * SZ_HALO <= SZ_TD2, "halo");
static_assert(WS_END <= (size_t)1 << 30, "workspace");

constexpr int STAGE_BYTES = 131072;
constexpr int LDS_BYTES = STAGE_BYTES + 8192 + 16;

struct Params {
    const float* x; const float* mem; const float* hgrn_lb; const float* norm1_w; const float* w_in; const float* hgrn_norm_w; const float* sconv_w;
    const float* w_out; const float* norm2_w; const float* mem_norm_w; const float* wq; const float* wk; const float* wv; const float* wo;
    const float* norm3_w; const float* w_gate; const float* w_up; const float* ffn_conv_w; const float* ffn_conv_b; const float* w_down; const float* final_norm_w;
    float* out; unsigned char* ws; int ph_lo, ph_hi;
};

typedef __bf16 bf16x2_t __attribute__((ext_vector_type(2)));
__device__ __forceinline__ unsigned cvt_pk_bf16_c(float lo, float hi) { const f32x2 v = {lo, hi}; return __builtin_bit_cast(unsigned, __builtin_convertvector(v, bf16x2_t)); }
__device__ __forceinline__ unsigned cvt_pk_bf16(float lo, float hi) { unsigned r; asm volatile("v_cvt_pk_bf16_f32 %0, %1, %2" : "=v"(r) : "v"(lo), "v"(hi)); return r; }
__device__ __forceinline__ float bf_lo(unsigned u) { return __uint_as_float(u << 16); }
__device__ __forceinline__ float bf_hi(unsigned u) { return __uint_as_float(u & 0xffff0000u); }
__device__ __forceinline__ float silu_f(float v) { return v * __builtin_amdgcn_rcpf(1.0f + __expf(-v)); }
__device__ __forceinline__ float wave_sum(float v) {
#pragma unroll
    for (int o = 32; o >= 1; o >>= 1) v += __shfl_xor(v, o);
    return v;
}

namespace pg8 {
constexpr int BM = 256, BK = 64, HALF = 128, HTB = HALF * BK * 2, NXCD = 8, WGM = 8;
__host__ __device__ __forceinline__ int lds_byte(int r, int c) { const int st = (r >> 4) * 2 + (c >> 5), rr = r & 15, cc = c & 31, ob = rr * 64 + cc * 2; return st * 1024 + (ob ^ (((ob >> 9) & 1) << 5)); }
__host__ __device__ __forceinline__ void stage_rc(int b, int& R, int& C) { const int st = b / 1024, sb = b % 1024, swz = sb ^ (((sb >> 9) & 1) << 5); R = (st >> 1) * 16 + swz / 64; C = (st & 1) * 32 + (swz % 64) / 2; }
__host__ __device__ __forceinline__ int perm32(int rho) { const int n = rho >> 4, i = rho & 15; return 8 * (i >> 2) + 4 * n + (i & 3); }

struct Unit { size_t aoff, boff; int pm, pn; };
struct Gemm { const bf16_t* A; const bf16_t* Bt; int lda, ldb, K; };

struct Order {
    int nM, nN, nwg, G, c, mode; size_t lda2, ldb2;
    __device__ void init(int nM_, int nN_, int mode_, int lda, int ldb, int crot = 0) { nM = nM_; nN = nN_; nwg = nM * nN; G = gridDim.x; c = (int)((blockIdx.x + crot) % gridDim.x); mode = mode_; lda2 = (size_t)lda * 2; ldb2 = (size_t)ldb * 2; }
    __device__ bool next(int i, Unit& u) const {
        const long L = (long)i * G + c; if (L >= nwg) return false;
        int wgid = (int)L; { const int q = nwg / NXCD, r = nwg % NXCD, xcd = wgid % NXCD, off = wgid / NXCD; wgid = (xcd < r ? xcd * (q + 1) : r * (q + 1) + (xcd - r) * q) + off; }
        const int nig = WGM * nN, gid = wgid / nig, fm = gid * WGM, gsz = (nM - fm) < WGM ? (nM - fm) : WGM;
        const int pm = fm + ((wgid % nig) % gsz), pn = (wgid % nig) / gsz;
        u.pm = pm; u.pn = pn;
        if (mode == 0) { u.aoff = (size_t)pm * 256 * lda2; u.boff = (size_t)pn * 256 * ldb2; }
        else if (mode == 3) { const int b = pm >> 2, h = pm & 3; u.aoff = (size_t)(b * 256) * lda2 + (size_t)h * 1024; u.boff = (size_t)pn * 256 * ldb2 + (size_t)h * 1024; }
        else if (mode == 4) { const int b = pm >> 3, nt_ = pm & 7, h = pn; u.aoff = (size_t)(nt_ * 256) * lda2 + (size_t)h * 1024; u.boff = (size_t)(b * 256) * ldb2 + (size_t)(2048 + h * 512) * 2; }
        else if (mode == 5) { const int b = pm >> 5; u.aoff = (size_t)pm * 256 * lda2; u.boff = (size_t)(b * 1024 + pn * 256) * ldb2; }
        else { const int b = pm >> 5; u.aoff = (size_t)pm * 256 * lda2; u.boff = (size_t)(b * 2048 + pn * 256) * ldb2; }
        return true;
    }
};

template <class Epi>
__device__ __forceinline__ void gemm_phase(LAS unsigned char* lds, const Gemm g, const Order& S, const Epi& E) {
    const int tid = threadIdx.x, wid = __builtin_amdgcn_readfirstlane(tid >> 6), lane = tid & 63, wr = wid >> 2, wc = wid & 3, fr = lane & 15, fq = lane >> 4;
    const int K = g.K, nt = K / BK;
    unsigned voffA[2], voffB[2];
#pragma unroll
    for (int i = 0; i < 2; ++i) { int R, C; stage_rc(tid * 16 + i * 8192, R, C); const int Rb = Epi::PERM ? ((R & ~31) + perm32(R & 31)) : R;
        voffA[i] = (unsigned)(R * g.lda + C) * 2u; voffB[i] = (unsigned)(Rb * g.ldb + C) * 2u; }
    const size_t kstep = (size_t)(BK * 2);
    const size_t hstepA = (size_t)HALF * g.lda * 2, hstepB = (size_t)HALF * g.ldb * 2;
    const unsigned ldsw = (unsigned)wid * 1024u;
    const int aoff = lds_byte(wr * 64 + fr, fq * 8), boff = lds_byte(wc * 32 + fr, fq * 8);
#define PG8_SA(b, h) (((b) * 2 + (h)) * HTB)
#define PG8_SB(b, h) ((4 + (b) * 2 + (h)) * HTB)
#define PG8_STAGE(bufoff, gbase, voff) do { _Pragma("unroll") for (int _i = 0; _i < 2; ++_i) \
        __builtin_amdgcn_global_load_lds((const unsigned*)((const char*)(gbase) + (voff)[_i]), (LAS unsigned*)(lds + (bufoff) + ldsw + _i * 8192), 16, 0, 0); } while (0)
#define PG8_LDA(dst, b, h) do { _Pragma("unroll") for (int m = 0; m < 4; ++m) _Pragma("unroll") for (int k = 0; k < 2; ++k) dst[m][k] = *(const LAS bf16x8*)(lds + PG8_SA(b, h) + aoff + m * 2048 + k * 1024); } while (0)
#define PG8_LDB(dst, b, h) do { _Pragma("unroll") for (int n = 0; n < 2; ++n) _Pragma("unroll") for (int k = 0; k < 2; ++k) dst[n][k] = *(const LAS bf16x8*)(lds + PG8_SB(b, h) + boff + n * 2048 + k * 1024); } while (0)
#define PG8_MMA(ai, bj, At, Bt) do { __builtin_amdgcn_s_setprio(1); _Pragma("unroll") for (int m = 0; m < 4; ++m) _Pragma("unroll") for (int n = 0; n < 2; ++n) _Pragma("unroll") for (int k = 0; k < 2; ++k) \
        acc[ai][bj][m][n] = __builtin_amdgcn_mfma_f32_16x16x32_bf16(Bt[n][k], At[m][k], acc[ai][bj][m][n], 0, 0, 0); __builtin_amdgcn_s_setprio(0); } while (0)
#define PG8_WAIT_V(n) asm volatile("s_waitcnt vmcnt(" #n ")" ::: "memory")
#define PG8_WAIT_L(n) asm volatile("s_waitcnt lgkmcnt(" #n ")" ::: "memory")
#define PG8_BAR __builtin_amdgcn_s_barrier()
#define PG8_SCHED __builtin_amdgcn_sched_barrier(0)
    Unit cur, nxt; int ui = 0;
    if (!S.next(0, cur)) return;
    f32x4 acc[2][2][4][2];
#pragma unroll
    for (int a = 0; a < 2; ++a)
#pragma unroll
        for (int b = 0; b < 2; ++b)
#pragma unroll
            for (int m = 0; m < 4; ++m)
#pragma unroll
                for (int n = 0; n < 2; ++n) acc[a][b][m][n] = (f32x4){0.f, 0.f, 0.f, 0.f};
    bf16x8 At[4][2], B0[2][2], B1[2][2];
    const char* cA = (const char*)g.A + cur.aoff; const char* cB = (const char*)g.Bt + cur.boff;
    PG8_STAGE(PG8_SB(0, 0), cB, voffB); PG8_STAGE(PG8_SB(0, 1), cB + hstepB, voffB); PG8_STAGE(PG8_SA(0, 0), cA, voffA); PG8_STAGE(PG8_SA(0, 1), cA + hstepA, voffA);
    if (wr == 1) PG8_BAR;
    PG8_WAIT_V(2); PG8_BAR;
    PG8_STAGE(PG8_SB(1, 0), cB + kstep, voffB); PG8_STAGE(PG8_SA(1, 0), cA + kstep, voffA); PG8_STAGE(PG8_SB(1, 1), cB + hstepB + kstep, voffB);
    PG8_WAIT_V(6); PG8_BAR;
    for (;;) {
        const bool has_next = S.next(ui + 1, nxt);
        const char* nA = has_next ? (const char*)g.A + nxt.aoff : cA; const char* nB = has_next ? (const char*)g.Bt + nxt.boff : cB;
        for (int t = 0; t < nt; t += 2) {
            const bool last = (t == nt - 2);
            const char* a1 = cA + (size_t)(t + 1) * kstep;
            const char* a2 = last ? nA : cA + (size_t)(t + 2) * kstep; const char* b2 = last ? nB : cB + (size_t)(t + 2) * kstep;
            const char* a3 = a2 + kstep; const char* b3 = b2 + kstep;
            PG8_LDB(B0, 0, 0); PG8_LDB(B1, 0, 1); PG8_SCHED; PG8_LDA(At, 0, 0); PG8_STAGE(PG8_SA(1, 1), a1 + hstepA, voffA);
            PG8_WAIT_V(8); PG8_WAIT_L(0); PG8_BAR; PG8_MMA(0, 0, At, B0); PG8_MMA(0, 1, At, B1); PG8_BAR; PG8_SCHED;
            PG8_LDA(At, 0, 1); PG8_STAGE(PG8_SB(0, 0), b2, voffB); PG8_STAGE(PG8_SB(0, 1), b2 + hstepB, voffB); PG8_STAGE(PG8_SA(0, 0), a2, voffA);
            PG8_WAIT_V(8); PG8_WAIT_L(0); PG8_BAR; PG8_MMA(1, 0, At, B0); PG8_MMA(1, 1, At, B1); PG8_BAR; PG8_SCHED;
            PG8_LDB(B0, 1, 0); PG8_LDB(B1, 1, 1); PG8_SCHED; PG8_LDA(At, 1, 0); PG8_STAGE(PG8_SA(0, 1), a2 + hstepA, voffA);
            PG8_WAIT_V(8); PG8_WAIT_L(0); PG8_BAR; PG8_MMA(0, 0, At, B0); PG8_MMA(0, 1, At, B1); PG8_BAR; PG8_SCHED;
            PG8_LDA(At, 1, 1); PG8_STAGE(PG8_SB(1, 0), b3, voffB); PG8_STAGE(PG8_SB(1, 1), b3 + hstepB, voffB); PG8_STAGE(PG8_SA(1, 0), a3, voffA);
            PG8_WAIT_V(8); PG8_WAIT_L(0); PG8_BAR; PG8_MMA(1, 0, At, B0); PG8_MMA(1, 1, At, B1); PG8_BAR; PG8_SCHED;
        }
        if (wr == 0) PG8_BAR;
        E(acc, cur, wr, wc, fr, fq);
        if (!has_next) break;
#pragma unroll
        for (int a = 0; a < 2; ++a)
#pragma unroll
            for (int b = 0; b < 2; ++b)
#pragma unroll
                for (int m = 0; m < 4; ++m)
#pragma unroll
                    for (int n = 0; n < 2; ++n) acc[a][b][m][n] = (f32x4){0.f, 0.f, 0.f, 0.f};
        cur = nxt; cA = nA; cB = nB; ++ui;
        if (wr == 1) PG8_BAR;
    }
    PG8_WAIT_V(0);
    PG8_BAR;
#undef PG8_SA
#undef PG8_SB
#undef PG8_STAGE
#undef PG8_LDA
#undef PG8_LDB
#undef PG8_MMA
#undef PG8_WAIT_V
#undef PG8_WAIT_L
#undef PG8_BAR
#undef PG8_SCHED
}

typedef f32x4 Acc[2][2][4][2];

struct EpiIn {
    static constexpr bool PERM = true;
    bf16_t* proj; float* logf; const float* lb;
    __device__ __forceinline__ void operator()(Acc& acc, const Unit& u, int wr, int wc, int fr, int fq) const {
        const int row0 = u.pm * 256 + wr * 64 + fr, sec = u.pn >> 2, colt = u.pn * 256 + wc * 32 + 8 * fq;
        if (sec == 1) {
#pragma unroll
            for (int bj = 0; bj < 2; ++bj) {
                const int c = colt + bj * 128 - 1024;
                const f32x4 l0 = *(const f32x4*)(lb + c), l1 = *(const f32x4*)(lb + c + 4);
#pragma unroll
                for (int ai = 0; ai < 2; ++ai)
#pragma unroll
                    for (int m = 0; m < 4; ++m) {
                        const size_t row = (size_t)(row0 + ai * 128 + m * 16);
                        f32x4 o0, o1;
#pragma unroll
                        for (int j = 0; j < 4; ++j) {
                            const float s0 = __builtin_amdgcn_rcpf(1.0f + __expf(-acc[ai][bj][m][0][j])), s1 = __builtin_amdgcn_rcpf(1.0f + __expf(-acc[ai][bj][m][1][j]));
                            o0[j] = __logf(l0[j] + (1.0f - l0[j]) * s0); o1[j] = __logf(l1[j] + (1.0f - l1[j]) * s1);
                        }
                        float* dst = logf + row * 1024 + c;
                        *(f32x4*)dst = o0; *(f32x4*)(dst + 4) = o1;
                    }
            }
        } else {
            const int cb = (sec == 0) ? colt : colt - 1024;
#pragma unroll
            for (int ai = 0; ai < 2; ++ai)
#pragma unroll
                for (int m = 0; m < 4; ++m) {
                    bf16_t* rowp = proj + (size_t)(row0 + ai * 128 + m * 16) * PJ + cb;
#pragma unroll
                    for (int bj = 0; bj < 2; ++bj) {
                        f32x4 v0 = acc[ai][bj][m][0], v1 = acc[ai][bj][m][1];
                        if (sec == 0) {
#pragma unroll
                            for (int j = 0; j < 4; ++j) { v0[j] = silu_f(v0[j]); v1[j] = silu_f(v1[j]); }
                        }
                        u32x4 w; w.x = cvt_pk_bf16(v0[0], v0[1]); w.y = cvt_pk_bf16(v0[2], v0[3]); w.z = cvt_pk_bf16(v1[0], v1[1]); w.w = cvt_pk_bf16(v1[2], v1[3]);
                        *(u32x4*)(rowp + bj * 128) = w;
                    }
                }
        }
    }
};

struct EpiB {
    static constexpr bool PERM = true;
    bf16_t* O; int ldc; const float* rss;
    __device__ __forceinline__ void operator()(Acc& acc, const Unit& u, int wr, int wc, int fr, int fq) const {
        const int row0 = u.pm * 256 + wr * 64 + fr, col0 = u.pn * 256 + wc * 32 + 8 * fq;
#pragma unroll
        for (int ai = 0; ai < 2; ++ai)
#pragma unroll
            for (int m = 0; m < 4; ++m) {
                const int row = row0 + ai * 128 + m * 16;
                const float s = rss ? rsqrtf(rss[row] * (1.0f / D) + EPS) : 1.0f;
                bf16_t* rowp = O + (size_t)row * ldc + col0;
#pragma unroll
                for (int bj = 0; bj < 2; ++bj) {
                    const f32x4 v0 = acc[ai][bj][m][0] * s, v1 = acc[ai][bj][m][1] * s;
                    u32x4 w; w.x = cvt_pk_bf16(v0[0], v0[1]); w.y = cvt_pk_bf16(v0[2], v0[3]); w.z = cvt_pk_bf16(v1[0], v1[1]); w.w = cvt_pk_bf16(v1[2], v1[3]);
                    *(u32x4*)(rowp + bj * 128) = w;
                }
            }
    }
};

template <bool XIN_BF16, bool OUT_F32, bool OUT_B, bool RSS> struct EpiRes {
    static constexpr bool PERM = true;
    const void* xin; float* xout; bf16_t* xb; float* rss;
    __device__ __forceinline__ void operator()(Acc& acc, const Unit& u, int wr, int wc, int fr, int fq) const {
        const int row0 = u.pm * 256 + wr * 64 + fr, col0 = u.pn * 256 + wc * 32 + 8 * fq;
#pragma unroll
        for (int ai = 0; ai < 2; ++ai) {
            f32x4 xi[4][2][2];
#pragma unroll
            for (int m = 0; m < 4; ++m)
#pragma unroll
                for (int bj = 0; bj < 2; ++bj) {
                    const size_t o = (size_t)(row0 + ai * 128 + m * 16) * D + col0 + bj * 128;
                    if (XIN_BF16) { const u32x4 r = *(const u32x4*)((const bf16_t*)xin + o);
                        xi[m][bj][0] = (f32x4){bf_lo(r.x), bf_hi(r.x), bf_lo(r.y), bf_hi(r.y)}; xi[m][bj][1] = (f32x4){bf_lo(r.z), bf_hi(r.z), bf_lo(r.w), bf_hi(r.w)}; }
                    else { xi[m][bj][0] = __builtin_nontemporal_load((const f32x4*)((const float*)xin + o)); xi[m][bj][1] = __builtin_nontemporal_load((const f32x4*)((const float*)xin + o + 4)); }
                }
#pragma unroll
            for (int m = 0; m < 4; ++m) {
                const size_t row = (size_t)(row0 + ai * 128 + m * 16);
                float ss = 0.f;
#pragma unroll
                for (int bj = 0; bj < 2; ++bj) {
                    const size_t o = row * D + col0 + bj * 128;
                    const f32x4 v0 = acc[ai][bj][m][0] + xi[m][bj][0], v1 = acc[ai][bj][m][1] + xi[m][bj][1];
                    if (OUT_F32) { *(f32x4*)(xout + o) = v0; *(f32x4*)(xout + o + 4) = v1; }
                    if (OUT_B) {
                        u32x4 w; w.x = cvt_pk_bf16(v0[0], v0[1]); w.y = cvt_pk_bf16(v0[2], v0[3]); w.z = cvt_pk_bf16(v1[0], v1[1]); w.w = cvt_pk_bf16(v1[2], v1[3]);
                        *(u32x4*)(xb + o) = w;
                        if (RSS) {
#pragma unroll
                            for (int j = 0; j < 4; ++j) ss += v0[j] * v0[j] + v1[j] * v1[j];
                        }
                    }
                }
                if (RSS) { ss += __shfl_xor(ss, 16); ss += __shfl_xor(ss, 32); if (fq == 0) atomicAdd(rss + row, ss); }
            }
        }
    }
};

struct EpiSm {
    static constexpr bool PERM = true;
    bf16_t* P; LAS float* xl; const float* rss;
    __device__ __forceinline__ void operator()(Acc& acc, const Unit& u, int wr, int wc, int fr, int fq) const {
        const float sc0 = 0.044194173824159216f * 1.4426950408889634f;
        const int rl0 = wr * 64 + fr;
        const int rowg0 = u.pm * 256 + wr * 64 + fr;
#pragma unroll
        for (int ai = 0; ai < 2; ++ai)
#pragma unroll
            for (int m = 0; m < 4; ++m) {
                float mx = -3.0e38f;
#pragma unroll
                for (int bj = 0; bj < 2; ++bj)
#pragma unroll
                    for (int n = 0; n < 2; ++n)
#pragma unroll
                        for (int j = 0; j < 4; ++j) mx = fmaxf(mx, acc[ai][bj][m][n][j]);
                mx = fmaxf(mx, __shfl_xor(mx, 16)); mx = fmaxf(mx, __shfl_xor(mx, 32));
                if (fq == 0) xl[(rl0 + ai * 128 + m * 16) * 4 + wc] = mx;
            }
        asm volatile("s_waitcnt lgkmcnt(0)" ::: "memory"); __builtin_amdgcn_s_barrier(); asm volatile("" ::: "memory");
#pragma unroll
        for (int ai = 0; ai < 2; ++ai)
#pragma unroll
            for (int m = 0; m < 4; ++m) {
                const int rl = rl0 + ai * 128 + m * 16;
                const f32x4 mm = *(const LAS f32x4*)(xl + rl * 4);
                const float sc = sc0 * rsqrtf(rss[rowg0 + ai * 128 + m * 16] * (1.0f / D) + EPS);
                const float M = fmaxf(fmaxf(mm[0], mm[1]), fmaxf(mm[2], mm[3])) * sc;
                float sum = 0.f;
#pragma unroll
                for (int bj = 0; bj < 2; ++bj)
#pragma unroll
                    for (int n = 0; n < 2; ++n)
#pragma unroll
                        for (int j = 0; j < 4; ++j) { const float pv = exp2f(acc[ai][bj][m][n][j] * sc - M); acc[ai][bj][m][n][j] = pv; sum += pv; }
                sum += __shfl_xor(sum, 16); sum += __shfl_xor(sum, 32);
                if (fq == 0) xl[1024 + rl * 4 + wc] = sum;
            }
        asm volatile("s_waitcnt lgkmcnt(0)" ::: "memory"); __builtin_amdgcn_s_barrier(); asm volatile("" ::: "memory");
        const int row0 = u.pm * 256 + wr * 64 + fr, col0 = u.pn * 256 + wc * 32 + 8 * fq;
#pragma unroll
        for (int ai = 0; ai < 2; ++ai)
#pragma unroll
            for (int m = 0; m < 4; ++m) {
                const int rl = rl0 + ai * 128 + m * 16;
                const f32x4 ss = *(const LAS f32x4*)(xl + 1024 + rl * 4);
                const float inv = 1.0f / (ss[0] + ss[1] + ss[2] + ss[3]);
                bf16_t* rowp = P + (size_t)(row0 + ai * 128 + m * 16) * 1024 + col0;
#pragma unroll
                for (int bj = 0; bj < 2; ++bj) {
                    const f32x4 v0 = acc[ai][bj][m][0] * inv, v1 = acc[ai][bj][m][1] * inv;
                    u32x4 w; w.x = cvt_pk_bf16(v0[0], v0[1]); w.y = cvt_pk_bf16(v0[2], v0[3]); w.z = cvt_pk_bf16(v1[0], v1[1]); w.w = cvt_pk_bf16(v1[2], v1[3]);
                    *(u32x4*)(rowp + bj * 128) = w;
                }
            }
    }
};

struct EpiGu {
    static constexpr bool PERM = true;
    bf16_t* act; const float* rss; const float* cw; const float* cbias; float* gf; float* uf; float* gl;
    __device__ __forceinline__ void operator()(Acc& acc, const Unit& u, int wr, int wc, int fr, int fq) const {
        const int row0 = u.pm * 256 + wr * 64 + fr, c0 = u.pn * 128 + wc * 32 + 8 * fq;
#pragma unroll
        for (int ai = 0; ai < 2; ++ai) {
            float rs[4];
#pragma unroll
            for (int m = 0; m < 4; ++m) rs[m] = rsqrtf(rss[row0 + ai * 128 + m * 16] * (1.0f / D) + EPS);
            const int blk = u.pm * 4 + ai * 2 + wr;
            unsigned pk[4][4];
#pragma unroll
            for (int n = 0; n < 2; ++n) {
                const f32x4 w0 = *(const f32x4*)(cw + c0 + 4 * n), w1 = *(const f32x4*)(cw + FF + c0 + 4 * n), w2 = *(const f32x4*)(cw + 2 * FF + c0 + 4 * n), bb = *(const f32x4*)(cbias + c0 + 4 * n);
#pragma unroll
                for (int jp = 0; jp < 2; ++jp) {
                    const f32x2 w0p = {w0[2 * jp], w0[2 * jp + 1]}, w1p = {w1[2 * jp], w1[2 * jp + 1]}, w2p = {w2[2 * jp], w2[2 * jp + 1]}, bbp = {bb[2 * jp], bb[2 * jp + 1]};
                    f32x2 gm[4], r1[4], r2[4];
#pragma unroll
                    for (int m = 0; m < 4; ++m) {
                        gm[m] = (f32x2){acc[ai][0][m][n][2 * jp], acc[ai][0][m][n][2 * jp + 1]} * rs[m];
                        r1[m].x = __int_as_float(__builtin_amdgcn_update_dpp(0, __float_as_int(gm[m].x), 0x121, 0xF, 0xF, false));
                        r1[m].y = __int_as_float(__builtin_amdgcn_update_dpp(0, __float_as_int(gm[m].y), 0x121, 0xF, 0xF, false));
                        r2[m].x = __int_as_float(__builtin_amdgcn_update_dpp(0, __float_as_int(gm[m].x), 0x122, 0xF, 0xF, false));
                        r2[m].y = __int_as_float(__builtin_amdgcn_update_dpp(0, __float_as_int(gm[m].y), 0x122, 0xF, 0xF, false));
                    }
#pragma unroll
                    for (int m = 0; m < 4; ++m) {
                        const f32x2 q1 = m >= 1 ? r1[m >= 1 ? m - 1 : 0] : (f32x2){0.f, 0.f}, q2 = m >= 1 ? r2[m >= 1 ? m - 1 : 0] : (f32x2){0.f, 0.f};
                        f32x2 p1, p2;
                        p1.x = (fr >= 1) ? r1[m].x : q1.x; p1.y = (fr >= 1) ? r1[m].y : q1.y;
                        p2.x = (fr >= 2) ? r2[m].x : q2.x; p2.y = (fr >= 2) ? r2[m].y : q2.y;
                        const f32x2 a = w2p * gm[m] + (w1p * p1 + (w0p * p2 + bbp));
                        const f32x2 na = a * (-1.4426950408889634f);
                        f32x2 den; den.x = __builtin_amdgcn_exp2f(na.x); den.y = __builtin_amdgcn_exp2f(na.y);
                        den = den + 1.0f;
                        f32x2 rc; rc.x = __builtin_amdgcn_rcpf(den.x); rc.y = __builtin_amdgcn_rcpf(den.y);
                        const f32x2 up = (f32x2){acc[ai][1][m][n][2 * jp], acc[ai][1][m][n][2 * jp + 1]} * rs[m];
                        const f32x2 ov = (a * rc) * up;
                        pk[m][2 * n + jp] = cvt_pk_bf16(ov.x, ov.y);
                    }
                }
            }
#pragma unroll
            for (int m = 0; m < 4; ++m) {
                const size_t row = (size_t)(row0 + ai * 128 + m * 16);
                if (!(m == 0 && fr < 2)) { u32x4 w; w.x = pk[m][0]; w.y = pk[m][1]; w.z = pk[m][2]; w.w = pk[m][3]; *(u32x4*)(act + row * FF + c0) = w; }
            }
            if (fr < 2) {
                const size_t o = ((size_t)blk * 2 + fr) * FF + c0;
                *(f32x4*)(gf + o) = acc[ai][0][0][0] * rs[0]; *(f32x4*)(gf + o + 4) = acc[ai][0][0][1] * rs[0];
                *(f32x4*)(uf + o) = acc[ai][1][0][0] * rs[0]; *(f32x4*)(uf + o + 4) = acc[ai][1][0][1] * rs[0];
            }
            if (fr >= 14) {
                const size_t o = ((size_t)blk * 2 + (fr - 14)) * FF + c0;
                *(f32x4*)(gl + o) = acc[ai][0][3][0] * rs[3]; *(f32x4*)(gl + o + 4) = acc[ai][0][3][1] * rs[3];
            }
        }
    }
};
}

__device__ __forceinline__ void transpose_tile(const float* __restrict__ src, int K, int N, bf16_t* __restrict__ dst, const float* __restrict__ scale, int k0, int n0, int rowmode, LAS float* tl) {
    const int tid = threadIdx.x;
    const int r = tid >> 6, c4 = (tid & 63) * 4;
    f32x4 v[8];
#pragma unroll
    for (int i = 0; i < 8; ++i) v[i] = __builtin_nontemporal_load((const f32x4*)(src + (size_t)(k0 + r + 8 * i) * N + n0 + c4));
#pragma unroll
    for (int i = 0; i < 8; ++i) {
        const int k = r + 8 * i;
        const float s = scale ? scale[k0 + k] : 1.0f;
        tl[k * 257 + c4 + 0] = v[i][0] * s; tl[k * 257 + c4 + 1] = v[i][1] * s; tl[k * 257 + c4 + 2] = v[i][2] * s; tl[k * 257 + c4 + 3] = v[i][3] * s;
    }
    __syncthreads();
    const int kg = (tid & 7) * 8;
#pragma unroll
    for (int q = 0; q < 4; ++q) {
        const int n = (tid >> 3) + 64 * q;
        float f[8];
#pragma unroll
        for (int j = 0; j < 8; ++j) f[j] = tl[(kg + j) * 257 + n];
        const int c = n0 + n;
        const int drow = rowmode == 0 ? c : (256 * (c >> 7) + (c & 127) + (rowmode == 2 ? 128 : 0));
        u32x4 w; w.x = cvt_pk_bf16(f[0], f[1]); w.y = cvt_pk_bf16(f[2], f[3]); w.z = cvt_pk_bf16(f[4], f[5]); w.w = cvt_pk_bf16(f[6], f[7]);
        *(u32x4*)(dst + (size_t)drow * K + k0 + kg) = w;
    }
    __syncthreads();
}

__device__ __forceinline__ void convert_tile(const float* __restrict__ src, int N, bf16_t* __restrict__ dst, const float* __restrict__ scale, int k0, int n0) {
    const int tid = threadIdx.x, r = tid >> 6, c4 = (tid & 63) * 4;
    f32x4 v[8];
#pragma unroll
    for (int i = 0; i < 8; ++i) v[i] = __builtin_nontemporal_load((const f32x4*)(src + (size_t)(k0 + r + 8 * i) * N + n0 + c4));
#pragma unroll
    for (int i = 0; i < 8; ++i) {
        const int k = k0 + r + 8 * i;
        const float sc = scale[k];
        u32x2 o; o.x = cvt_pk_bf16(v[i][0] * sc, v[i][1] * sc); o.y = cvt_pk_bf16(v[i][2] * sc, v[i][3] * sc);
        *(u32x2*)(dst + (size_t)k * N + n0 + c4) = o;
    }
}

__device__ __forceinline__ void rmsnorm_row_bf16(const float* __restrict__ src, const float* __restrict__ w, bf16_t* __restrict__ dst, int lane) {
    f32x4 v[8]; float ss = 0.f;
#pragma unroll
    for (int i = 0; i < 8; ++i) { v[i] = __builtin_nontemporal_load((const f32x4*)(src + i * 256 + lane * 4)); ss += v[i][0] * v[i][0] + v[i][1] * v[i][1] + v[i][2] * v[i][2] + v[i][3] * v[i][3]; }
    ss = wave_sum(ss);
    const float rstd = rsqrtf(ss * (1.0f / D) + EPS);
#pragma unroll
    for (int i = 0; i < 8; ++i) {
        const f32x4 g = *(const f32x4*)(w + i * 256 + lane * 4);
        u32x2 o; o.x = cvt_pk_bf16(v[i][0] * rstd * g[0], v[i][1] * rstd * g[1]); o.y = cvt_pk_bf16(v[i][2] * rstd * g[2], v[i][3] * rstd * g[3]);
        *(u32x2*)(dst + i * 256 + lane * 4) = o;
    }
}

__device__ void phase_prep(const Params& p, LAS unsigned char* lds) {
    const int tid = threadIdx.x, lane = tid & 63, w = tid >> 6;
    unsigned char* ws = p.ws;
    for (int t = blockIdx.x; t < 896 + 5 * 256; t += gridDim.x) {
        if (t < 896) { const int tk = t / 28, tn = t % 28; transpose_tile(p.w_in, D, INC, (bf16_t*)(ws + WS_WIN), nullptr, tk * 64, tn * 256, 0, (LAS float*)lds); }
        else { const int q = (t - 896) >> 8, r = (t - 896) & 255, tk = r >> 3, tn = r & 7;
            const float* src = q == 0 ? p.w_out : q == 1 ? p.wq : q == 2 ? p.wk : q == 3 ? p.wv : p.wo;
            const size_t off = q == 0 ? WS_WOUT : q == 1 ? WS_WQ : q == 2 ? WS_WK : q == 3 ? WS_WV : WS_WO;
            if (q == 1) convert_tile(src, D, (bf16_t*)(ws + off), p.norm2_w, tk * 64, tn * 256);
            else transpose_tile(src, D, D, (bf16_t*)(ws + off), nullptr, tk * 64, tn * 256, 0, (LAS float*)lds); }
    }
    for (int r = blockIdx.x * 8 + w; r < T + 1024; r += gridDim.x * 8) {
        if (r < T) rmsnorm_row_bf16(p.x + (size_t)r * D, p.norm1_w, (bf16_t*)(ws + WS_H) + (size_t)r * D, lane);
        else rmsnorm_row_bf16(p.mem + (size_t)(r - T) * D, p.mem_norm_w, (bf16_t*)(ws + WS_MEMN) + (size_t)(r - T) * D, lane);
    }
    for (int i = blockIdx.x * 512 + tid; i < 2 * T; i += gridDim.x * 512) ((float*)(ws + WS_RSS2))[i] = 0.f;
    for (int i = blockIdx.x * 512 + tid; i < 1024; i += gridDim.x * 512) { const float a0 = p.hgrn_lb[i], a1 = p.hgrn_lb[1024 + i]; ((float*)(ws + WS_LB))[i] = 1.0f / (1.0f + __expf(a1 - a0)); }
}

__device__ void phase_ffn_weights(const Params& p, LAS unsigned char* lds) {
    unsigned char* ws = p.ws;
    for (int t = blockIdx.x; t < 3 * 704; t += gridDim.x) {
        const int q = t / 704, r = t % 704;
        if (q < 2) { const int tk = r / 22, tn = r % 22; transpose_tile(q == 0 ? p.w_gate : p.w_up, D, FF, (bf16_t*)(ws + WS_WGU), p.norm3_w, tk * 64, tn * 256, 1 + q, (LAS float*)lds); }
        else { const int tk = r >> 3, tn = r & 7; transpose_tile(p.w_down, FF, D, (bf16_t*)(ws + WS_WDN), nullptr, tk * 64, tn * 256, 0, (LAS float*)lds); }
    }
}

#define LDS_BARRIER() do { asm volatile("s_waitcnt lgkmcnt(0)" ::: "memory"); __builtin_amdgcn_s_barrier(); asm volatile("" ::: "memory"); } while (0)
__device__ __forceinline__ int hgrn_item_of(int slot, bool deal) {
    if (!deal) { const int item = blockIdx.x + slot * gridDim.x; return item < 4096 ? item : -1; }
    const int c = blockIdx.x;
    if (c < 64) return slot < 3 ? c + 256 * slot : -1;
    if (slot < 16) return c + 256 * slot;
    if (slot >= 21) return -1;
    const int r = (slot - 16) * 192 + (c - 64);
    return r < 832 ? (3 + (r >> 6)) * 256 + (r & 63) : -1;
}

__device__ void phase_hgrn_local(const Params& p, LAS unsigned char* lds) {
    const int tid = threadIdx.x, lane = tid & 63, w = tid >> 6, fr = lane & 15, fq = lane >> 4;
    LAS bf16_t* Ak = (LAS bf16_t*)(lds);
    LAS bf16_t* Vt = (LAS bf16_t*)(lds + 18432);
    LAS float* tots = (LAS float*)(lds + 36864);
    const float* logf = (const float*)(p.ws + WS_LOGF);
    const bf16_t* proj = (const bf16_t*)(p.ws + WS_B0);
    bf16_t* us = (bf16_t*)(p.ws + WS_US);
    float* dec = (float*)(p.ws + WS_DEC);
    const bool deal = (gridDim.x == 256);
    const int kp = lane, sg = w;
    f32x2 c[8]; unsigned vv[8];
#define HL_LOAD(ITEM) do { const int _it = (ITEM); const int _bh = _it >> 7, _n = _it & 127, _b = _bh >> 3, _h = _bh & 7; const size_t _t0 = (size_t)_b * SEQ + (size_t)_n * 64; \
        _Pragma("unroll") for (int i = 0; i < 8; ++i) { c[i] = *(const f32x2*)(logf + (_t0 + 8 * sg + i) * 1024 + _h * 128 + 2 * kp); vv[i] = *(const unsigned*)(proj + (_t0 + 8 * sg + i) * PJ + 1024 + _h * 128 + 2 * kp); } } while (0)
    int item = hgrn_item_of(0, deal);
    if (item >= 0) HL_LOAD(item);
    for (int slot = 0; item >= 0; ++slot) {
        const int nitem = hgrn_item_of(slot + 1, deal);
        f32x2 kk[8];
#pragma unroll
        for (int i = 0; i < 8; ++i) { kk[i].x = 1.0f - __expf(c[i].x); kk[i].y = 1.0f - __expf(c[i].y); }
#pragma unroll
        for (int i = 1; i < 8; ++i) c[i] += c[i - 1];
        *(LAS f32x2*)(tots + sg * 128 + 2 * kp) = c[7];
        LDS_BARRIER();
        f32x2 off = {0.f, 0.f}, tot = {0.f, 0.f};
#pragma unroll
        for (int g = 0; g < 8; ++g) { const f32x2 tv = *(const LAS f32x2*)(tots + g * 128 + 2 * kp); if (g < sg) off += tv; tot += tv; }
        float e0[8], e1[8];
#pragma unroll
        for (int i = 0; i < 8; ++i) { e0[i] = kk[i].x * __expf(tot.x - off.x - c[i].x); e1[i] = kk[i].y * __expf(tot.y - off.y - c[i].y); }
        u32x4 a0, a1, v0, v1;
        a0.x = cvt_pk_bf16(e0[0], e0[1]); a0.y = cvt_pk_bf16(e0[2], e0[3]); a0.z = cvt_pk_bf16(e0[4], e0[5]); a0.w = cvt_pk_bf16(e0[6], e0[7]);
        a1.x = cvt_pk_bf16(e1[0], e1[1]); a1.y = cvt_pk_bf16(e1[2], e1[3]); a1.z = cvt_pk_bf16(e1[4], e1[5]); a1.w = cvt_pk_bf16(e1[6], e1[7]);
        v0.x = (vv[0] & 0xffffu) | (vv[1] << 16); v0.y = (vv[2] & 0xffffu) | (vv[3] << 16); v0.z = (vv[4] & 0xffffu) | (vv[5] << 16); v0.w = (vv[6] & 0xffffu) | (vv[7] << 16);
        v1.x = (vv[0] >> 16) | (vv[1] & 0xffff0000u); v1.y = (vv[2] >> 16) | (vv[3] & 0xffff0000u); v1.z = (vv[4] >> 16) | (vv[5] & 0xffff0000u); v1.w = (vv[6] >> 16) | (vv[7] & 0xffff0000u);
        *(LAS u32x4*)(Ak + (2 * kp) * 72 + 8 * sg) = a0; *(LAS u32x4*)(Ak + (2 * kp + 1) * 72 + 8 * sg) = a1;
        *(LAS u32x4*)(Vt + (2 * kp) * 72 + 8 * sg) = v0; *(LAS u32x4*)(Vt + (2 * kp + 1) * 72 + 8 * sg) = v1;
        if (sg == 0) { f32x2 d; d.x = __expf(tot.x); d.y = __expf(tot.y); *(f32x2*)(dec + (size_t)item * 128 + 2 * kp) = d; }
        if (nitem >= 0) HL_LOAD(nitem);
        LDS_BARRIER();
        f32x4 acc[8];
#pragma unroll
        for (int kt = 0; kt < 8; ++kt) acc[kt] = (f32x4){0.f, 0.f, 0.f, 0.f};
#pragma unroll
        for (int ks = 0; ks < 2; ++ks) {
            const bf16x8 bq = *(const LAS bf16x8*)(Vt + (16 * w + fr) * 72 + 32 * ks + 8 * fq);
#pragma unroll
            for (int kt = 0; kt < 8; ++kt) { const bf16x8 a = *(const LAS bf16x8*)(Ak + (16 * kt + fr) * 72 + 32 * ks + 8 * fq); acc[kt] = __builtin_amdgcn_mfma_f32_16x16x32_bf16(a, bq, acc[kt], 0, 0, 0); }
        }
        bf16_t* dst = us + (size_t)item * 16384 + (16 * w + fr) * 128 + 4 * fq;
#pragma unroll
        for (int kt = 0; kt < 8; ++kt) { u32x2 o; o.x = cvt_pk_bf16_c(acc[kt][0], acc[kt][1]); o.y = cvt_pk_bf16_c(acc[kt][2], acc[kt][3]); *(u32x2*)(dst + 16 * kt) = o; }
        LDS_BARRIER();
        item = nitem;
    }
#undef HL_LOAD
}

__device__ void phase_hgrn_scan(const Params& p) {
    const bf16_t* us = (const bf16_t*)(p.ws + WS_US);
    bf16_t* sb = (bf16_t*)p.out;
    const float* dec = (const float*)(p.ws + WS_DEC);
    for (int idx = blockIdx.x * 512 + threadIdx.x; idx < 32 * 4096; idx += gridDim.x * 512) {
        const int bh = idx >> 12, e = (idx & 4095) * 4, k = e & 127;
        const bf16_t* base = us + (size_t)bh * 128 * 16384 + e;
        bf16_t* obase = sb + (size_t)bh * 128 * 16384 + e;
        const float* dbase = dec + (size_t)bh * 128 * 128 + k;
        f32x4 s = {0.f, 0.f, 0.f, 0.f};
        for (int n0 = 0; n0 < 128; n0 += 8) {
            u32x2 uu[8]; f32x4 dd[8];
#pragma unroll
            for (int i = 0; i < 8; ++i) { uu[i] = __builtin_nontemporal_load((const u32x2*)(base + (size_t)(n0 + i) * 16384)); dd[i] = *(const f32x4*)(dbase + (n0 + i) * 128); }
#pragma unroll
            for (int i = 0; i < 8; ++i) {
                u32x2 o; o.x = cvt_pk_bf16(s[0], s[1]); o.y = cvt_pk_bf16(s[2], s[3]);
                *(u32x2*)(obase + (size_t)(n0 + i) * 16384) = o;
                const f32x4 u4 = {bf_lo(uu[i].x), bf_hi(uu[i].x), bf_lo(uu[i].y), bf_hi(uu[i].y)};
                s = s * dd[i] + u4;
            }
        }
    }
}

__device__ void phase_hgrn_out(const Params& p, LAS unsigned char* lds) {
    const int tid = threadIdx.x, lane = tid & 63, w = tid >> 6, fr = lane & 15, fq = lane >> 4;
    LAS bf16_t* Qe = (LAS bf16_t*)(lds);
    LAS bf16_t* Ke = (LAS bf16_t*)(lds + 17408);
    LAS bf16_t* St = (LAS bf16_t*)(lds + 34816);
    LAS bf16_t* Vt = (LAS bf16_t*)(lds + 69632);
    LAS bf16_t* Pm = (LAS bf16_t*)(lds + 88064);
    LAS float* tots = (LAS float*)(lds + 97280);
    LAS float* ssq = (LAS float*)(lds + 101376);
    const float* logf = (const float*)(p.ws + WS_LOGF);
    const bf16_t* proj = (const bf16_t*)(p.ws + WS_B0);
    const bf16_t* us = (const bf16_t*)p.out;
    bf16_t* mix = (bf16_t*)(p.ws + WS_H);
    const int kp = lane, sg = w;
    f32x2 c[8]; unsigned vv[8], qv[8]; u32x2 sv[8];
#define HG_LOAD_PRE(ITEM) do { const int _it = (ITEM); const int _bh = _it >> 7, _n = _it & 127, _b = _bh >> 3, _h = _bh & 7; const size_t _t0 = (size_t)_b * SEQ + (size_t)_n * 64; \
        _Pragma("unroll") for (int i = 0; i < 8; ++i) { const size_t t = _t0 + 8 * sg + i; \
            c[i] = __builtin_nontemporal_load((const f32x2*)(logf + t * 1024 + _h * 128 + 2 * kp)); qv[i] = __builtin_nontemporal_load((const unsigned*)(proj + t * PJ + _h * 128 + 2 * kp)); vv[i] = __builtin_nontemporal_load((const unsigned*)(proj + t * PJ + 1024 + _h * 128 + 2 * kp)); } \
        _Pragma("unroll") for (int i = 0; i < 8; ++i) { const int idx = tid + 512 * i; sv[i] = __builtin_nontemporal_load((const u32x2*)(us + (size_t)_it * 16384 + (idx >> 5) * 128 + (idx & 31) * 4)); } } while (0)
    if ((int)blockIdx.x < 4096) HG_LOAD_PRE(blockIdx.x);
    for (int item = blockIdx.x; item < 4096; item += gridDim.x) {
        const int bh = item >> 7, n = item & 127, b = bh >> 3, h = bh & 7;
        const size_t t0 = (size_t)b * SEQ + (size_t)n * 64;
        f32x2 kk[8];
#pragma unroll
        for (int i = 0; i < 8; ++i) { kk[i].x = 1.0f - __expf(c[i].x); kk[i].y = 1.0f - __expf(c[i].y); }
#pragma unroll
        for (int i = 1; i < 8; ++i) c[i] += c[i - 1];
        *(LAS f32x2*)(tots + sg * 128 + 2 * kp) = c[7];
        LDS_BARRIER();
        f32x2 off = {0.f, 0.f}, tot = {0.f, 0.f};
#pragma unroll
        for (int g = 0; g < 8; ++g) { const f32x2 tv = *(const LAS f32x2*)(tots + g * 128 + 2 * kp); if (g < sg) off += tv; tot += tv; }
        const f32x2 ref = tot * 0.5f;
#pragma unroll
        for (int i = 0; i < 8; ++i) {
            const float bx = off.x + c[i].x - ref.x, by = off.y + c[i].y - ref.y;
            const int t = 8 * sg + i;
            *(LAS unsigned*)(Qe + t * 136 + 2 * kp) = cvt_pk_bf16(bf_lo(qv[i]) * __expf(bx), bf_hi(qv[i]) * __expf(by));
            *(LAS unsigned*)(Ke + t * 136 + 2 * kp) = cvt_pk_bf16(kk[i].x * __expf(-bx), kk[i].y * __expf(-by));
        }
        {
            u32x4 v0, v1;
            v0.x = (vv[0] & 0xffffu) | (vv[1] << 16); v0.y = (vv[2] & 0xffffu) | (vv[3] << 16); v0.z = (vv[4] & 0xffffu) | (vv[5] << 16); v0.w = (vv[6] & 0xffffu) | (vv[7] << 16);
            v1.x = (vv[0] >> 16) | (vv[1] & 0xffff0000u); v1.y = (vv[2] >> 16) | (vv[3] & 0xffff0000u); v1.z = (vv[4] >> 16) | (vv[5] & 0xffff0000u); v1.w = (vv[6] >> 16) | (vv[7] & 0xffff0000u);
            *(LAS u32x4*)(Vt + (2 * kp) * 72 + 8 * sg) = v0; *(LAS u32x4*)(Vt + (2 * kp + 1) * 72 + 8 * sg) = v1;
        }
        {
            const int k4 = (tid & 31) * 4;
            f32x4 tt = {0.f, 0.f, 0.f, 0.f};
#pragma unroll
            for (int g = 0; g < 8; ++g) tt += *(const LAS f32x4*)(tots + g * 128 + k4);
            const f32x4 er = {__expf(0.5f * tt[0]), __expf(0.5f * tt[1]), __expf(0.5f * tt[2]), __expf(0.5f * tt[3])};
#pragma unroll
            for (int i = 0; i < 8; ++i) {
                const int v = (tid >> 5) + 16 * i;
                u32x2 o; o.x = cvt_pk_bf16(bf_lo(sv[i].x) * er[0], bf_hi(sv[i].x) * er[1]); o.y = cvt_pk_bf16(bf_lo(sv[i].y) * er[2], bf_hi(sv[i].y) * er[3]);
                *(LAS u32x2*)(St + v * 136 + k4) = o;
            }
        }
        const int tb = w >> 1, hf = w & 1, tl = 16 * tb + fr;
        u32x2 gg[4];
#pragma unroll
        for (int i = 0; i < 4; ++i) gg[i] = __builtin_nontemporal_load((const u32x2*)(proj + (t0 + tl) * PJ + 2048 + h * 128 + 16 * (4 * hf + i) + 4 * fq));
        const int cc_ = h * 128 + (tid & 31) * 4, tr = tid >> 5;
        u32x2 za[6], zb[6], cbv[4];
#pragma unroll
        for (int r = 0; r < 6; ++r) {
            const int tt = 4 * tr + r - 2;
            if (tt < 0 && n == 0) { za[r] = (u32x2){0u, 0u}; zb[r] = (u32x2){0u, 0u}; }
            else { const bf16_t* rp = proj + (size_t)((long)t0 + tt) * PJ; za[r] = *(const u32x2*)(rp + 4096 + cc_); zb[r] = *(const u32x2*)(rp + 5120 + cc_); }
        }
#pragma unroll
        for (int i = 0; i < 4; ++i) cbv[i] = __builtin_nontemporal_load((const u32x2*)(proj + (t0 + 4 * tr + i) * PJ + 3072 + cc_));
        if (item + (int)gridDim.x < 4096) HG_LOAD_PRE(item + (int)gridDim.x);
        LDS_BARRIER();
#pragma unroll
        for (int s2 = 0; s2 < 2; ++s2) {
            const int st = 2 * hf + s2;
            f32x4 a4 = {0.f, 0.f, 0.f, 0.f};
            if (st <= tb) {
#pragma unroll
                for (int ks = 0; ks < 4; ++ks) {
                    const bf16x8 a = *(const LAS bf16x8*)(Ke + (16 * st + fr) * 136 + 32 * ks + 8 * fq);
                    const bf16x8 bq = *(const LAS bf16x8*)(Qe + tl * 136 + 32 * ks + 8 * fq);
                    a4 = __builtin_amdgcn_mfma_f32_16x16x32_bf16(a, bq, a4, 0, 0, 0);
                }
            }
            const int s0 = 16 * st + 4 * fq;
            u32x2 o; o.x = cvt_pk_bf16(s0 + 0 <= tl ? a4[0] : 0.f, s0 + 1 <= tl ? a4[1] : 0.f); o.y = cvt_pk_bf16(s0 + 2 <= tl ? a4[2] : 0.f, s0 + 3 <= tl ? a4[3] : 0.f);
            *(LAS u32x2*)(Pm + tl * 72 + s0) = o;
        }
        LDS_BARRIER();
        f32x4 ao[4];
#pragma unroll
        for (int i = 0; i < 4; ++i) ao[i] = (f32x4){0.f, 0.f, 0.f, 0.f};
#pragma unroll
        for (int ks = 0; ks < 4; ++ks) {
            const bf16x8 bq = *(const LAS bf16x8*)(Qe + tl * 136 + 32 * ks + 8 * fq);
#pragma unroll
            for (int i = 0; i < 4; ++i) { const bf16x8 a = *(const LAS bf16x8*)(St + (16 * (4 * hf + i) + fr) * 136 + 32 * ks + 8 * fq); ao[i] = __builtin_amdgcn_mfma_f32_16x16x32_bf16(a, bq, ao[i], 0, 0, 0); }
        }
#pragma unroll
        for (int ks = 0; ks < 2; ++ks) {
            const bf16x8 bq = *(const LAS bf16x8*)(Pm + tl * 72 + 32 * ks + 8 * fq);
#pragma unroll
            for (int i = 0; i < 4; ++i) { const bf16x8 a = *(const LAS bf16x8*)(Vt + (16 * (4 * hf + i) + fr) * 72 + 32 * ks + 8 * fq); ao[i] = __builtin_amdgcn_mfma_f32_16x16x32_bf16(a, bq, ao[i], 0, 0, 0); }
        }
        float ss = 0.f;
#pragma unroll
        for (int i = 0; i < 4; ++i)
#pragma unroll
            for (int j = 0; j < 4; ++j) ss += ao[i][j] * ao[i][j];
        ss += __shfl_xor(ss, 16); ss += __shfl_xor(ss, 32);
        if (fq == 0) ssq[tl * 2 + hf] = ss;
        LDS_BARRIER();
        const float rstd = rsqrtf((ssq[tl * 2] + ssq[tl * 2 + 1]) * (1.0f / 128.0f) + EPS);
#pragma unroll
        for (int i = 0; i < 4; ++i) {
            const int v0 = 16 * (4 * hf + i) + 4 * fq;
            const f32x4 nw = *(const f32x4*)(p.hgrn_norm_w + v0);
            u32x2 o;
            o.x = cvt_pk_bf16(ao[i][0] * rstd * nw[0] * silu_f(bf_lo(gg[i].x)), ao[i][1] * rstd * nw[1] * silu_f(bf_hi(gg[i].x)));
            o.y = cvt_pk_bf16(ao[i][2] * rstd * nw[2] * silu_f(bf_lo(gg[i].y)), ao[i][3] * rstd * nw[3] * silu_f(bf_hi(gg[i].y)));
            *(u32x2*)(mix + (t0 + tl) * D + h * 128 + v0) = o;
        }
        {
            const f32x4 w0 = *(const f32x4*)(p.sconv_w + cc_), w1 = *(const f32x4*)(p.sconv_w + 1024 + cc_), w2 = *(const f32x4*)(p.sconv_w + 2048 + cc_);
            f32x4 z[6];
#pragma unroll
            for (int r = 0; r < 6; ++r) z[r] = (f32x4){bf_lo(za[r].x) * bf_lo(zb[r].x), bf_hi(za[r].x) * bf_hi(zb[r].x), bf_lo(za[r].y) * bf_lo(zb[r].y), bf_hi(za[r].y) * bf_hi(zb[r].y)};
#pragma unroll
            for (int i = 0; i < 4; ++i) {
                const size_t t = t0 + 4 * tr + i;
                const f32x4 y = w0 * z[i] + w1 * z[i + 1] + w2 * z[i + 2];
                u32x2 o; o.x = cvt_pk_bf16(bf_lo(cbv[i].x) * y[0], bf_hi(cbv[i].x) * y[1]); o.y = cvt_pk_bf16(bf_lo(cbv[i].y) * y[2], bf_hi(cbv[i].y) * y[3]);
                *(u32x2*)(mix + t * D + 1024 + cc_) = o;
            }
        }
        LDS_BARRIER();
    }
#undef HG_LOAD_PRE
}

__device__ void phase_fixup(const Params& p) {
    const float* gf = (const float*)(p.ws + WS_GF); const float* uf = (const float*)(p.ws + WS_UF); const float* gl = (const float*)(p.ws + WS_GL);
    bf16_t* act = (bf16_t*)(p.ws + WS_ACT);
    const int per = FF / 4;
    for (int idx = blockIdx.x * 512 + threadIdx.x; idx < 512 * 2 * per; idx += gridDim.x * 512) {
        const int c = (idx % per) * 4, br = idx / per, r = br & 1, blk = br >> 1;
        const bool first = (blk & 127) == 0;
        const f32x4 zero = {0.f, 0.f, 0.f, 0.f};
        const f32x4 g0 = *(const f32x4*)(gf + ((size_t)blk * 2 + r) * FF + c);
        f32x4 g1, g2;
        if (r == 0) { g1 = first ? zero : *(const f32x4*)(gl + ((size_t)(blk - 1) * 2 + 1) * FF + c); g2 = first ? zero : *(const f32x4*)(gl + ((size_t)(blk - 1) * 2) * FF + c); }
        else { g1 = *(const f32x4*)(gf + ((size_t)blk * 2) * FF + c); g2 = first ? zero : *(const f32x4*)(gl + ((size_t)(blk - 1) * 2 + 1) * FF + c); }
        const f32x4 uu = *(const f32x4*)(uf + ((size_t)blk * 2 + r) * FF + c);
        const f32x4 w0 = *(const f32x4*)(p.ffn_conv_w + c), w1 = *(const f32x4*)(p.ffn_conv_w + FF + c), w2 = *(const f32x4*)(p.ffn_conv_w + 2 * FF + c), bb = *(const f32x4*)(p.ffn_conv_b + c);
        const f32x4 a = w2 * g0 + w1 * g1 + w0 * g2 + bb;
        u32x2 o; o.x = cvt_pk_bf16(silu_f(a[0]) * uu[0], silu_f(a[1]) * uu[1]); o.y = cvt_pk_bf16(silu_f(a[2]) * uu[2], silu_f(a[3]) * uu[3]);
        *(u32x2*)(act + ((size_t)blk * 64 + r) * FF + c) = o;
    }
}

__device__ void phase_final(const Params& p) {
    const int lane = threadIdx.x & 63, w = threadIdx.x >> 6;
    const bf16_t* x3 = (const bf16_t*)(p.ws + WS_B0);
    for (int r = blockIdx.x * 8 + w; r < T; r += gridDim.x * 8) {
        const bf16_t* src = x3 + (size_t)r * D;
        float* row = p.out + (size_t)r * D;
        u32x4 v[4]; float ss = 0.f;
#pragma unroll
        for (int i = 0; i < 4; ++i) {
            v[i] = *(const u32x4*)(src + i * 512 + lane * 8);
            const float a0 = bf_lo(v[i].x), a1 = bf_hi(v[i].x), a2 = bf_lo(v[i].y), a3 = bf_hi(v[i].y), a4 = bf_lo(v[i].z), a5 = bf_hi(v[i].z), a6 = bf_lo(v[i].w), a7 = bf_hi(v[i].w);
            ss += a0 * a0 + a1 * a1 + a2 * a2 + a3 * a3 + a4 * a4 + a5 * a5 + a6 * a6 + a7 * a7;
        }
        ss = wave_sum(ss);
        const float rstd = rsqrtf(ss * (1.0f / D) + EPS);
#pragma unroll
        for (int i = 0; i < 4; ++i) {
            const f32x4 g0 = *(const f32x4*)(p.final_norm_w + i * 512 + lane * 8), g1 = *(const f32x4*)(p.final_norm_w + i * 512 + lane * 8 + 4);
            f32x4 o0 = {bf_lo(v[i].x), bf_hi(v[i].x), bf_lo(v[i].y), bf_hi(v[i].y)}, o1 = {bf_lo(v[i].z), bf_hi(v[i].z), bf_lo(v[i].w), bf_hi(v[i].w)};
            __builtin_nontemporal_store(o0 * rstd * g0, (f32x4*)(row + i * 512 + lane * 8)); __builtin_nontemporal_store(o1 * rstd * g1, (f32x4*)(row + i * 512 + lane * 8 + 4));
        }
    }
}

#define XB_TMO      128
#define XB_XCNT(j)  (256  + 64 * (j))
#define XB_XSUB(j)  (1280 + 64 * (j))
#define XB_XGEN(j)  (2304 + 64 * (j))
#define XB_TOP      3328
#define XB_TOPGEN   3392
#define XCD_BAR_WORDS 3456
#define XB_SPIN_CAP (1u << 21)
__device__ __forceinline__ unsigned xb_ld(unsigned* p)              { return __hip_atomic_load(p, __ATOMIC_RELAXED, __HIP_MEMORY_SCOPE_AGENT); }
__device__ __forceinline__ unsigned xb_add(unsigned* p, unsigned v) { return __hip_atomic_fetch_add(p, v, __ATOMIC_RELAXED, __HIP_MEMORY_SCOPE_AGENT); }
__device__ __forceinline__ unsigned xb_xcc_id() { return (unsigned)__builtin_amdgcn_s_getreg((3 << 11) | 20) & 0xFu; }
#define XB_SPIN(cond, bar) do { unsigned _sp = 0; while (cond) { __builtin_amdgcn_s_sleep(1); \
    if ((++_sp & 255u) == 0u) { if (xb_ld(&(bar)[XB_TMO])) break; if (_sp > XB_SPIN_CAP) { atomicAdd(&(bar)[XB_TMO], 1u); break; } } } } while (0)
struct XcdBarrier { unsigned* bar; unsigned x; volatile LAS unsigned* st; };
__device__ __forceinline__ XcdBarrier xcd_barrier_post(unsigned* bar, volatile LAS unsigned* st) {
    XcdBarrier b; b.bar = bar; b.x = xb_xcc_id(); b.st = st;
    if (threadIdx.x == 0) (void)xb_add(&bar[XB_XCNT(b.x)], 1u);
    return b;
}
__device__ __forceinline__ void xcd_barrier_complete(unsigned* bar, unsigned x, unsigned& nloc, unsigned& nx) {
    const unsigned G = gridDim.x * gridDim.y * gridDim.z;
    unsigned sum, cnt, mine, sp = 0u;
    for (;;) {
        sum = 0u; cnt = 0u; mine = 0u;
#pragma unroll
        for (unsigned j = 0; j < 16; ++j) { const unsigned c = xb_ld(&bar[XB_XCNT(j)]); sum += c; cnt += (c > 0u) ? 1u : 0u; mine = (j == x) ? c : mine; }
        if (sum == G) break;
        __builtin_amdgcn_s_sleep(1);
        if ((++sp & 255u) == 0u) { if (xb_ld(&bar[XB_TMO])) break; if (sp > XB_SPIN_CAP) { atomicAdd(&bar[XB_TMO], 1u); break; } }
    }
    nloc = mine > 0u ? mine : 1u; nx = cnt > 0u ? cnt : 1u;
}
__device__ __forceinline__ void xcd_barrier(const XcdBarrier& b) {
    asm volatile("s_waitcnt vmcnt(0)" ::: "memory");
    __syncthreads();
    if (threadIdx.x == 0) {
        unsigned* bar = b.bar;
        __builtin_amdgcn_s_waitcnt(0);
        unsigned nloc = b.st[0], nx = b.st[1];
        if (nloc == 0u) { xcd_barrier_complete(bar, b.x, nloc, nx); b.st[0] = nloc; b.st[1] = nx; }
        const unsigned old = xb_add(&bar[XB_XSUB(b.x)], 1u);
        const unsigned gen = old / nloc;
        if (old + 1u == (gen + 1u) * nloc) {
            __builtin_amdgcn_fence(__ATOMIC_RELEASE, "agent");
            asm volatile("s_waitcnt vmcnt(0)" ::: "memory");
            const unsigned og = xb_add(&bar[XB_TOP], 1u);
            const unsigned tg = og / nx;
            if (og + 1u == (tg + 1u) * nx) xb_add(&bar[XB_TOPGEN], 1u);
            else XB_SPIN(xb_ld(&bar[XB_TOPGEN]) == tg, bar);
            __builtin_amdgcn_fence(__ATOMIC_ACQUIRE, "agent");
            xb_add(&bar[XB_XGEN(b.x)], 1u);
            asm volatile("s_waitcnt vmcnt(0)" ::: "memory");
        } else {
            XB_SPIN(xb_ld(&bar[XB_XGEN(b.x)]) == gen, bar);
            __builtin_amdgcn_fence(__ATOMIC_ACQUIRE, "agent");
            asm volatile("s_waitcnt vmcnt(0)" ::: "memory");
        }
    }
    __syncthreads();
}

__global__ void __launch_bounds__(512) fwd_megakernel(Params p) {
    extern __shared__ __attribute__((aligned(16))) unsigned char smem[];
    LAS unsigned char* lds = (LAS unsigned char*)smem;
    unsigned char* ws = p.ws;
    bf16_t* const H = (bf16_t*)(ws + WS_H); bf16_t* const B0 = (bf16_t*)(ws + WS_B0); bf16_t* const B1 = (bf16_t*)(ws + WS_B1); bf16_t* const B2 = (bf16_t*)(ws + WS_B2);
    float* const rss2 = (float*)(ws + WS_RSS2); float* const rss3 = (float*)(ws + WS_RSS3);
#define RUN(k) (PH_ON(k) && p.ph_lo <= (k) && (k) <= p.ph_hi)
    volatile LAS unsigned* stw = (volatile LAS unsigned*)(lds + STAGE_BYTES + 8192);
    if (threadIdx.x < 4) stw[threadIdx.x] = 0u;
    __syncthreads();
    XcdBarrier xbar; xbar.bar = (unsigned*)(ws + WS_BAR); xbar.x = 0u; xbar.st = stw;
    if (p.ph_lo < p.ph_hi) xbar = xcd_barrier_post((unsigned*)(ws + WS_BAR), stw);
    if (p.ph_hi > 1000) cg::this_grid().sync();
#define SEAM(k) do { if (p.ph_lo <= (k) && (k) < p.ph_hi) xcd_barrier(xbar); } while (0)
    if (RUN(0)) { phase_prep(p, lds); }
    SEAM(0);
    if (RUN(1)) {
        { pg8::Gemm g{H, (const bf16_t*)(ws + WS_WIN), D, D, D}; pg8::Order S; S.init(T / 256, INC / 256, 0, D, D);
          pg8::EpiIn E{B0, (float*)(ws + WS_LOGF), (const float*)(ws + WS_LB)}; pg8::gemm_phase(lds, g, S, E); }
    }
    SEAM(1);
    if (RUN(2)) {
        { pg8::Gemm g{(const bf16_t*)(ws + WS_MEMN), (const bf16_t*)(ws + WS_WK), D, D, D}; pg8::Order S; S.init(4, 16, 0, D, D);
          pg8::EpiB E{(bf16_t*)(ws + WS_KP), 2 * D, nullptr}; pg8::gemm_phase(lds, g, S, E); }
        phase_hgrn_local(p, lds);
    }
    SEAM(2);
    if (RUN(3)) {
        { pg8::Gemm g{(const bf16_t*)(ws + WS_KP), (const bf16_t*)(ws + WS_WQ), 2 * D, D, 512}; pg8::Order S; S.init(16, 8, 3, 2 * D, D);
          pg8::EpiB E{(bf16_t*)(ws + WS_WQK), D, nullptr}; pg8::gemm_phase(lds, g, S, E); }
        { pg8::Gemm g{(const bf16_t*)(ws + WS_WO), (const bf16_t*)(ws + WS_KP), D, 2 * D, 512}; pg8::Order S; S.init(32, 4, 4, D, 2 * D, 128);
          pg8::EpiB E{(bf16_t*)(ws + WS_WVO), 1024, nullptr}; pg8::gemm_phase(lds, g, S, E); }
        phase_hgrn_scan(p);
    }
    SEAM(3);
    if (RUN(4)) { phase_hgrn_out(p, lds); }
    SEAM(4);
    if (RUN(5)) {
        pg8::Gemm g{H, (const bf16_t*)(ws + WS_WOUT), D, D, D}; pg8::Order S; S.init(T / 256, D / 256, 0, D, D);
        pg8::EpiRes<false, false, true, true> E{p.x, nullptr, B0, rss2}; pg8::gemm_phase(lds, g, S, E);
    }
    SEAM(5);
    if (RUN(6)) {
        phase_ffn_weights(p, lds);
        pg8::Gemm g{B0, (const bf16_t*)(ws + WS_WQK), D, D, D}; pg8::Order S; S.init(T / 256, 4, 5, D, D);
        pg8::EpiSm E{B2, (LAS float*)(lds + STAGE_BYTES), rss2}; pg8::gemm_phase(lds, g, S, E);
    }
    SEAM(6);
    if (RUN(7)) {
        pg8::Gemm g{B2, (const bf16_t*)(ws + WS_WVO), 1024, 1024, 1024}; pg8::Order S; S.init(T / 256, D / 256, 6, 1024, 1024);
        pg8::EpiRes<true, false, true, true> E{B0, nullptr, B0, rss3}; pg8::gemm_phase(lds, g, S, E);
    }
    SEAM(7);
    if (RUN(8)) {
        pg8::Gemm g{B0, (const bf16_t*)(ws + WS_WGU), D, D, D}; pg8::Order S; S.init(T / 256, 2 * FF / 256, 0, D, D);
        pg8::EpiGu E{(bf16_t*)(ws + WS_ACT), rss3, p.ffn_conv_w, p.ffn_conv_b, (float*)(ws + WS_GF), (float*)(ws + WS_UF), (float*)(ws + WS_GL)}; pg8::gemm_phase(lds, g, S, E);
    }
    SEAM(8);
    if (RUN(9)) { phase_fixup(p); }
    SEAM(9);
    if (RUN(10)) {
        pg8::Gemm g{(const bf16_t*)(ws + WS_ACT), (const bf16_t*)(ws + WS_WDN), FF, FF, FF}; pg8::Order S; S.init(T / 256, D / 256, 0, FF, FF);
        pg8::EpiRes<true, false, true, false> E{B0, nullptr, B0, nullptr}; pg8::gemm_phase(lds, g, S, E);
    }
    SEAM(10);
    if (RUN(11)) { phase_final(p); }
}

extern "C" void kernel_launch(void* const* d_in, const int* in_sizes, int n_in, void* d_out, int out_size, void* d_ws, size_t ws_size, hipStream_t stream) {
    static int grid = 0;
    if (grid == 0) {
        if (n_in != 21 || ws_size < WS_END) { fprintf(stderr, "kernel_launch: unexpected inputs (%d) or workspace (%zu < %zu)\n", n_in, ws_size, (size_t)WS_END); grid = -1; return; }
        int dev = 0, cus = 0, per_cu = 0;
        hipGetDevice(&dev);
        hipDeviceGetAttribute(&cus, hipDeviceAttributeMultiprocessorCount, dev);
        if (hipFuncSetAttribute((const void*)fwd_megakernel, hipFuncAttributeMaxDynamicSharedMemorySize, LDS_BYTES) != hipSuccess) { fprintf(stderr, "kernel_launch: hipFuncSetAttribute failed\n"); grid = -1; return; }
        if (hipOccupancyMaxActiveBlocksPerMultiprocessor(&per_cu, (const void*)fwd_megakernel, 512, LDS_BYTES) != hipSuccess || per_cu < 1) { (void)hipGetLastError(); per_cu = 1; }
        grid = cus * per_cu;
    }
    if (grid < 0) return;
    Params p{};
    const float** f = (const float**)&p;
    for (int i = 0; i < 21; ++i) f[i] = (const float*)d_in[i];
    p.out = (float*)d_out; p.ws = (unsigned char*)d_ws;
#if MULTI_LAUNCH
    for (int ph = 0; ph < NPHASE; ++ph) {
        p.ph_lo = ph; p.ph_hi = ph;
        hipLaunchKernelGGL(fwd_megakernel, dim3(grid), dim3(512), LDS_BYTES, stream, p);
    }
#else
    p.ph_lo = 0; p.ph_hi = NPHASE - 1;
    if (hipMemsetAsync((char*)d_ws + WS_BAR, 0, XCD_BAR_WORDS * 4, stream) != hipSuccess) { fprintf(stderr, "kernel_launch: hipMemsetAsync failed\n"); return; }
    void* args[] = {&p};
    hipError_t e = hipLaunchCooperativeKernel((const void*)fwd_megakernel, dim3(grid), dim3(512), args, LDS_BYTES, stream);
    if (e != hipSuccess) fprintf(stderr, "cooperative launch failed: %s (grid %d)\n", hipGetErrorString(e), grid);
#endif
}
```

```cpp
#include <hip/hip_runtime.h>
#include <hip/hip_cooperative_groups.h>
#include <cstdio>
namespace cg = cooperative_groups;

#ifndef MULTI_LAUNCH
#define MULTI_LAUNCH 0
#endif

#ifndef ONLY_PHASE
#define ONLY_PHASE -1
#endif
#define PH_ON(k) (ONLY_PHASE < 0 || ONLY_PHASE == (k))

#define LAS __attribute__((address_space(3)))
typedef unsigned short bf16_t;
typedef short bf16x8 __attribute__((ext_vector_type(8)));
typedef float f32x4 __attribute__((ext_vector_type(4)));
typedef float f32x2 __attribute__((ext_vector_type(2)));
typedef unsigned u32x4 __attribute__((ext_vector_type(4)));
typedef unsigned u32x2 __attribute__((ext_vector_type(2)));

constexpr int T = 32768, D = 2048, SEQ = 8192;
constexpr int INC = 7168, PJ = 6144;
constexpr int FF = 5632;
constexpr float EPS = 1e-6f;
constexpr int NPHASE = 12;

constexpr size_t SZ_TD2 = (size_t)T * D * 2;
constexpr size_t WS_WIN = 0;
constexpr size_t WS_WOUT = WS_WIN + (size_t)INC * D * 2;
constexpr size_t WS_WQ = WS_WOUT + (size_t)D * D * 2;
constexpr size_t WS_WK = WS_WQ + (size_t)D * D * 2;
constexpr size_t WS_WV = WS_WK + (size_t)D * D * 2;
constexpr size_t WS_WO = WS_WV + (size_t)D * D * 2;
constexpr size_t WS_H = WS_WO + (size_t)D * D * 2;
constexpr size_t WS_B0 = WS_H + SZ_TD2;
constexpr size_t WS_B1 = WS_B0 + SZ_TD2;
constexpr size_t WS_B2 = WS_B1 + SZ_TD2;
constexpr size_t WS_LOGF = WS_B2 + SZ_TD2;
constexpr size_t WS_US = WS_LOGF + SZ_TD2;
constexpr size_t WS_MEMN = WS_US + (size_t)4096 * 16384 * 4;
constexpr size_t WS_KP = WS_MEMN + (size_t)1024 * D * 2;
constexpr size_t WS_VT = WS_KP + (size_t)1024 * D * 2;
constexpr size_t WS_DEC = WS_VT + (size_t)1024 * D * 2;
constexpr size_t WS_RSS2 = WS_DEC + (size_t)4096 * 128 * 4;
constexpr size_t WS_RSS3 = WS_RSS2 + (size_t)T * 4;
constexpr size_t WS_LB = WS_RSS3 + (size_t)T * 4;
constexpr size_t WS_WQK = WS_LB + 4096;
constexpr size_t WS_WVO = WS_WQK + (size_t)4 * 1024 * D * 2;
constexpr size_t WS_BAR = WS_WVO + (size_t)4 * D * 1024 * 2;
constexpr size_t WS_END = WS_BAR + 16384;
constexpr size_t WS_WGU = WS_US;
constexpr size_t WS_WDN = WS_US + (size_t)2 * FF * D * 2;
constexpr size_t WS_ACT = WS_B1;
constexpr size_t SZ_HALO = (size_t)512 * 2 * FF * 4;
constexpr size_t WS_GF = WS_H, WS_UF = WS_H + SZ_HALO, WS_GL = WS_H + 2 * SZ_HALO;
static_assert(WS_ACT + (size_t)T * FF * 2 <= WS_US, "act overlaps FFN weights");
static_assert(3 * SZ_HALO <= SZ_TD2, "halo");
static_assert(WS_END <= (size_t)1 << 30, "workspace");

constexpr int STAGE_BYTES = 131072;
constexpr int LDS_BYTES = STAGE_BYTES + 8192 + 16;

struct Params {
    const float* x; const float* mem; const float* hgrn_lb; const float* norm1_w; const float* w_in; const float* hgrn_norm_w; const float* sconv_w;
    const float* w_out; const float* norm2_w; const float* mem_norm_w; const float* wq; const float* wk; const float* wv; const float* wo;
    const float* norm3_w; const float* w_gate; const float* w_up; const float* ffn_conv_w; const float* ffn_conv_b; const float* w_down; const float* final_norm_w;
    float* out; unsigned char* ws; int ph_lo, ph_hi;
};

typedef __bf16 bf16x2_t __attribute__((ext_vector_type(2)));
__device__ __forceinline__ unsigned cvt_pk_bf16_c(float lo, float hi) { const f32x2 v = {lo, hi}; return __builtin_bit_cast(unsigned, __builtin_convertvector(v, bf16x2_t)); }
__device__ __forceinline__ unsigned cvt_pk_bf16(float lo, float hi) { unsigned r; asm volatile("v_cvt_pk_bf16_f32 %0, %1, %2" : "=v"(r) : "v"(lo), "v"(hi)); return r; }
__device__ __forceinline__ float bf_lo(unsigned u) { return __uint_as_float(u << 16); }
__device__ __forceinline__ float bf_hi(unsigned u) { return __uint_as_float(u & 0xffff0000u); }
__device__ __forceinline__ float silu_f(float v) { return v * __builtin_amdgcn_rcpf(1.0f + __expf(-v)); }
__device__ __forceinline__ float wave_sum(float v) {
#pragma unroll
    for (int o = 32; o >= 1; o >>= 1) v += __shfl_xor(v, o);
    return v;
}

namespace pg8 {
constexpr int BM = 256, BK = 64, HALF = 128, HTB = HALF * BK * 2, NXCD = 8, WGM = 8;
__host__ __device__ __forceinline__ int lds_byte(int r, int c) { const int st = (r >> 4) * 2 + (c >> 5), rr = r & 15, cc = c & 31, ob = rr * 64 + cc * 2; return st * 1024 + (ob ^ (((ob >> 9) & 1) << 5)); }
__host__ __device__ __forceinline__ void stage_rc(int b, int& R, int& C) { const int st = b / 1024, sb = b % 1024, swz = sb ^ (((sb >> 9) & 1) << 5); R = (st >> 1) * 16 + swz / 64; C = (st & 1) * 32 + (swz % 64) / 2; }
__host__ __device__ __forceinline__ int perm32(int rho) { const int n = rho >> 4, i = rho & 15; return 8 * (i >> 2) + 4 * n + (i & 3); }

struct Unit { size_t aoff, boff; int pm, pn; };
struct Gemm { const bf16_t* A; const bf16_t* Bt; int lda, ldb, K; };

struct Order {
    int nM, nN, nwg, G, c, mode; size_t lda2, ldb2;
    __device__ void init(int nM_, int nN_, int mode_, int lda, int ldb, int crot = 0) { nM = nM_; nN = nN_; nwg = nM * nN; G = gridDim.x; c = (int)((blockIdx.x + crot) % gridDim.x); mode = mode_; lda2 = (size_t)lda * 2; ldb2 = (size_t)ldb * 2; }
    __device__ bool next(int i, Unit& u) const {
        const long L = (long)i * G + c; if (L >= nwg) return false;
        int wgid = (int)L; { const int q = nwg / NXCD, r = nwg % NXCD, xcd = wgid % NXCD, off = wgid / NXCD; wgid = (xcd < r ? xcd * (q + 1) : r * (q + 1) + (xcd - r) * q) + off; }
        const int nig = WGM * nN, gid = wgid / nig, fm = gid * WGM, gsz = (nM - fm) < WGM ? (nM - fm) : WGM;
        const int pm = fm + ((wgid % nig) % gsz), pn = (wgid % nig) / gsz;
        u.pm = pm; u.pn = pn;
        if (mode == 0) { u.aoff = (size_t)pm * 256 * lda2; u.boff = (size_t)pn * 256 * ldb2; }
        else if (mode == 3) { const int b = pm >> 2, h = pm & 3; u.aoff = (size_t)(b * 256) * lda2 + (size_t)h * 1024; u.boff = (size_t)pn * 256 * ldb2 + (size_t)h * 1024; }
        else if (mode == 4) { const int b = pm >> 3, nt_ = pm & 7, h = pn; u.aoff = (size_t)(nt_ * 256) * lda2 + (size_t)h * 1024; u.boff = (size_t)(b * 256) * ldb2 + (size_t)(2048 + h * 512) * 2; }
        else if (mode == 5) { const int b = pm >> 5; u.aoff = (size_t)pm * 256 * lda2; u.boff = (size_t)(b * 1024 + pn * 256) * ldb2; }
        else { const int b = pm >> 5; u.aoff = (size_t)pm * 256 * lda2; u.boff = (size_t)(b * 2048 + pn * 256) * ldb2; }
        return true;
    }
};

template <class Epi>
__device__ __forceinline__ void gemm_phase(LAS unsigned char* lds, const Gemm g, const Order& S, const Epi& E) {
    const int tid = threadIdx.x, wid = __builtin_amdgcn_readfirstlane(tid >> 6), lane = tid & 63, wr = wid >> 2, wc = wid & 3, fr = lane & 15, fq = lane >> 4;
    const int K = g.K, nt = K / BK;
    unsigned voffA[2], voffB[2];
#pragma unroll
    for (int i = 0; i < 2; ++i) { int R, C; stage_rc(tid * 16 + i * 8192, R, C); const int Rb = Epi::PERM ? ((R & ~31) + perm32(R & 31)) : R;
        voffA[i] = (unsigned)(R * g.lda + C) * 2u; voffB[i] = (unsigned)(Rb * g.ldb + C) * 2u; }
    const size_t kstep = (size_t)(BK * 2);
    const size_t hstepA = (size_t)HALF * g.lda * 2, hstepB = (size_t)HALF * g.ldb * 2;
    const unsigned ldsw = (unsigned)wid * 1024u;
    const int aoff = lds_byte(wr * 64 + fr, fq * 8), boff = lds_byte(wc * 32 + fr, fq * 8);
#define PG8_SA(b, h) (((b) * 2 + (h)) * HTB)
#define PG8_SB(b, h) ((4 + (b) * 2 + (h)) * HTB)
#define PG8_STAGE(bufoff, gbase, voff) do { _Pragma("unroll") for (int _i = 0; _i < 2; ++_i) \
        __builtin_amdgcn_global_load_lds((const unsigned*)((const char*)(gbase) + (voff)[_i]), (LAS unsigned*)(lds + (bufoff) + ldsw + _i * 8192), 16, 0, 0); } while (0)
#define PG8_LDA(dst, b, h) do { _Pragma("unroll") for (int m = 0; m < 4; ++m) _Pragma("unroll") for (int k = 0; k < 2; ++k) dst[m][k] = *(const LAS bf16x8*)(lds + PG8_SA(b, h) + aoff + m * 2048 + k * 1024); } while (0)
#define PG8_LDB(dst, b, h) do { _Pragma("unroll") for (int n = 0; n < 2; ++n) _Pragma("unroll") for (int k = 0; k < 2; ++k) dst[n][k] = *(const LAS bf16x8*)(lds + PG8_SB(b, h) + boff + n * 2048 + k * 1024); } while (0)
#define PG8_MMA(ai, bj, At, Bt) do { __builtin_amdgcn_s_setprio(1); _Pragma("unroll") for (int m = 0; m < 4; ++m) _Pragma("unroll") for (int n = 0; n < 2; ++n) _Pragma("unroll") for (int k = 0; k < 2; ++k) \
        acc[ai][bj][m][n] = __builtin_amdgcn_mfma_f32_16x16x32_bf16(Bt[n][k], At[m][k], acc[ai][bj][m][n], 0, 0, 0); __builtin_amdgcn_s_setprio(0); } while (0)
#define PG8_WAIT_V(n) asm volatile("s_waitcnt vmcnt(" #n ")" ::: "memory")
#define PG8_WAIT_L(n) asm volatile("s_waitcnt lgkmcnt(" #n ")" ::: "memory")
#define PG8_BAR __builtin_amdgcn_s_barrier()
#define PG8_SCHED __builtin_amdgcn_sched_barrier(0)
    Unit cur, nxt; int ui = 0;
    if (!S.next(0, cur)) return;
    f32x4 acc[2][2][4][2];
#pragma unroll
    for (int a = 0; a < 2; ++a)
#pragma unroll
        for (int b = 0; b < 2; ++b)
#pragma unroll
            for (int m = 0; m < 4; ++m)
#pragma unroll
                for (int n = 0; n < 2; ++n) acc[a][b][m][n] = (f32x4){0.f, 0.f, 0.f, 0.f};
    bf16x8 At[4][2], B0[2][2], B1[2][2];
    const char* cA = (const char*)g.A + cur.aoff; const char* cB = (const char*)g.Bt + cur.boff;
    PG8_STAGE(PG8_SB(0, 0), cB, voffB); PG8_STAGE(PG8_SB(0, 1), cB + hstepB, voffB); PG8_STAGE(PG8_SA(0, 0), cA, voffA); PG8_STAGE(PG8_SA(0, 1), cA + hstepA, voffA);
    if (wr == 1) PG8_BAR;
    PG8_WAIT_V(2); PG8_BAR;
    PG8_STAGE(PG8_SB(1, 0), cB + kstep, voffB); PG8_STAGE(PG8_SA(1, 0), cA + kstep, voffA); PG8_STAGE(PG8_SB(1, 1), cB + hstepB + kstep, voffB);
    PG8_WAIT_V(6); PG8_BAR;
    for (;;) {
        const bool has_next = S.next(ui + 1, nxt);
        const char* nA = has_next ? (const char*)g.A + nxt.aoff : cA; const char* nB = has_next ? (const char*)g.Bt + nxt.boff : cB;
        for (int t = 0; t < nt; t += 2) {
            const bool last = (t == nt - 2);
            const char* a1 = cA + (size_t)(t + 1) * kstep;
            const char* a2 = last ? nA : cA + (size_t)(t + 2) * kstep; const char* b2 = last ? nB : cB + (size_t)(t + 2) * kstep;
            const char* a3 = a2 + kstep; const char* b3 = b2 + kstep;
            PG8_LDB(B0, 0, 0); PG8_LDB(B1, 0, 1); PG8_SCHED; PG8_LDA(At, 0, 0); PG8_STAGE(PG8_SA(1, 1), a1 + hstepA, voffA);
            PG8_WAIT_V(8); PG8_WAIT_L(0); PG8_BAR; PG8_MMA(0, 0, At, B0); PG8_MMA(0, 1, At, B1); PG8_BAR; PG8_SCHED;
            PG8_LDA(At, 0, 1); PG8_STAGE(PG8_SB(0, 0), b2, voffB); PG8_STAGE(PG8_SB(0, 1), b2 + hstepB, voffB); PG8_STAGE(PG8_SA(0, 0), a2, voffA);
            PG8_WAIT_V(8); PG8_WAIT_L(0); PG8_BAR; PG8_MMA(1, 0, At, B0); PG8_MMA(1, 1, At, B1); PG8_BAR; PG8_SCHED;
            PG8_LDB(B0, 1, 0); PG8_LDB(B1, 1, 1); PG8_SCHED; PG8_LDA(At, 1, 0); PG8_STAGE(PG8_SA(0, 1), a2 + hstepA, voffA);
            PG8_WAIT_V(8); PG8_WAIT_L(0); PG8_BAR; PG8_MMA(0, 0, At, B0); PG8_MMA(0, 1, At, B1); PG8_BAR; PG8_SCHED;
            PG8_LDA(At, 1, 1); PG8_STAGE(PG8_SB(1, 0), b3, voffB); PG8_STAGE(PG8_SB(1, 1), b3 + hstepB, voffB); PG8_STAGE(PG8_SA(1, 0), a3, voffA);
            PG8_WAIT_V(8); PG8_WAIT_L(0); PG8_BAR; PG8_MMA(1, 0, At, B0); PG8_MMA(1, 1, At, B1); PG8_BAR; PG8_SCHED;
        }
        if (wr == 0) PG8_BAR;
        E(acc, cur, wr, wc, fr, fq);
        if (!has_next) break;
#pragma unroll
        for (int a = 0; a < 2; ++a)
#pragma unroll
            for (int b = 0; b < 2; ++b)
#pragma unroll
                for (int m = 0; m < 4; ++m)
#pragma unroll
                    for (int n = 0; n < 2; ++n) acc[a][b][m][n] = (f32x4){0.f, 0.f, 0.f, 0.f};
        cur = nxt; cA = nA; cB = nB; ++ui;
        if (wr == 1) PG8_BAR;
    }
    PG8_WAIT_V(0);
    PG8_BAR;
#undef PG8_SA
#undef PG8_SB
#undef PG8_STAGE
#undef PG8_LDA
#undef PG8_LDB
#undef PG8_MMA
#undef PG8_WAIT_V
#undef PG8_WAIT_L
#undef PG8_BAR
#undef PG8_SCHED
}

typedef f32x4 Acc[2][2][4][2];

struct EpiIn {
    static constexpr bool PERM = true;
    bf16_t* proj; float* logf; const float* lb;
    __device__ __forceinline__ void operator()(Acc& acc, const Unit& u, int wr, int wc, int fr, int fq) const {
        const int row0 = u.pm * 256 + wr * 64 + fr, sec = u.pn >> 2, colt = u.pn * 256 + wc * 32 + 8 * fq;
        if (sec == 1) {
#pragma unroll
            for (int bj = 0; bj < 2; ++bj) {
                const int c = colt + bj * 128 - 1024;
                const f32x4 l0 = *(const f32x4*)(lb + c), l1 = *(const f32x4*)(lb + c + 4);
#pragma unroll
                for (int ai = 0; ai < 2; ++ai)
#pragma unroll
                    for (int m = 0; m < 4; ++m) {
                        const size_t row = (size_t)(row0 + ai * 128 + m * 16);
                        f32x4 o0, o1;
#pragma unroll
                        for (int j = 0; j < 4; ++j) {
                            const float s0 = __builtin_amdgcn_rcpf(1.0f + __expf(-acc[ai][bj][m][0][j])), s1 = __builtin_amdgcn_rcpf(1.0f + __expf(-acc[ai][bj][m][1][j]));
                            o0[j] = __logf(l0[j] + (1.0f - l0[j]) * s0); o1[j] = __logf(l1[j] + (1.0f - l1[j]) * s1);
                        }
                        float* dst = logf + row * 1024 + c;
                        *(f32x4*)dst = o0; *(f32x4*)(dst + 4) = o1;
                    }
            }
        } else {
            const int cb = (sec == 0) ? colt : colt - 1024;
#pragma unroll
            for (int ai = 0; ai < 2; ++ai)
#pragma unroll
                for (int m = 0; m < 4; ++m) {
                    bf16_t* rowp = proj + (size_t)(row0 + ai * 128 + m * 16) * PJ + cb;
#pragma unroll
                    for (int bj = 0; bj < 2; ++bj) {
                        f32x4 v0 = acc[ai][bj][m][0], v1 = acc[ai][bj][m][1];
                        if (sec == 0) {
#pragma unroll
                            for (int j = 0; j < 4; ++j) { v0[j] = silu_f(v0[j]); v1[j] = silu_f(v1[j]); }
                        }
                        u32x4 w; w.x = cvt_pk_bf16(v0[0], v0[1]); w.y = cvt_pk_bf16(v0[2], v0[3]); w.z = cvt_pk_bf16(v1[0], v1[1]); w.w = cvt_pk_bf16(v1[2], v1[3]);
                        *(u32x4*)(rowp + bj * 128) = w;
                    }
                }
        }
    }
};

struct EpiB {
    static constexpr bool PERM = true;
    bf16_t* O; int ldc; const float* rss;
    __device__ __forceinline__ void operator()(Acc& acc, const Unit& u, int wr, int wc, int fr, int fq) const {
        const int row0 = u.pm * 256 + wr * 64 + fr, col0 = u.pn * 256 + wc * 32 + 8 * fq;
#pragma unroll
        for (int ai = 0; ai < 2; ++ai)
#pragma unroll
            for (int m = 0; m < 4; ++m) {
                const int row = row0 + ai * 128 + m * 16;
                const float s = rss ? rsqrtf(rss[row] * (1.0f / D) + EPS) : 1.0f;
                bf16_t* rowp = O + (size_t)row * ldc + col0;
#pragma unroll
                for (int bj = 0; bj < 2; ++bj) {
                    const f32x4 v0 = acc[ai][bj][m][0] * s, v1 = acc[ai][bj][m][1] * s;
                    u32x4 w; w.x = cvt_pk_bf16(v0[0], v0[1]); w.y = cvt_pk_bf16(v0[2], v0[3]); w.z = cvt_pk_bf16(v1[0], v1[1]); w.w = cvt_pk_bf16(v1[2], v1[3]);
                    *(u32x4*)(rowp + bj * 128) = w;
                }
            }
    }
};

template <bool XIN_BF16, bool OUT_F32, bool OUT_B, bool RSS> struct EpiRes {
    static constexpr bool PERM = true;
    const void* xin; float* xout; bf16_t* xb; float* rss;
    __device__ __forceinline__ void operator()(Acc& acc, const Unit& u, int wr, int wc, int fr, int fq) const {
        const int row0 = u.pm * 256 + wr * 64 + fr, col0 = u.pn * 256 + wc * 32 + 8 * fq;
#pragma unroll
        for (int ai = 0; ai < 2; ++ai) {
            f32x4 xi[4][2][2];
#pragma unroll
            for (int m = 0; m < 4; ++m)
#pragma unroll
                for (int bj = 0; bj < 2; ++bj) {
                    const size_t o = (size_t)(row0 + ai * 128 + m * 16) * D + col0 + bj * 128;
                    if (XIN_BF16) { const u32x4 r = *(const u32x4*)((const bf16_t*)xin + o);
                        xi[m][bj][0] = (f32x4){bf_lo(r.x), bf_hi(r.x), bf_lo(r.y), bf_hi(r.y)}; xi[m][bj][1] = (f32x4){bf_lo(r.z), bf_hi(r.z), bf_lo(r.w), bf_hi(r.w)}; }
                    else { xi[m][bj][0] = __builtin_nontemporal_load((const f32x4*)((const float*)xin + o)); xi[m][bj][1] = __builtin_nontemporal_load((const f32x4*)((const float*)xin + o + 4)); }
                }
#pragma unroll
            for (int m = 0; m < 4; ++m) {
                const size_t row = (size_t)(row0 + ai * 128 + m * 16);
                float ss = 0.f;
#pragma unroll
                for (int bj = 0; bj < 2; ++bj) {
                    const size_t o = row * D + col0 + bj * 128;
                    const f32x4 v0 = acc[ai][bj][m][0] + xi[m][bj][0], v1 = acc[ai][bj][m][1] + xi[m][bj][1];
                    if (OUT_F32) { *(f32x4*)(xout + o) = v0; *(f32x4*)(xout + o + 4) = v1; }
                    if (OUT_B) {
                        u32x4 w; w.x = cvt_pk_bf16(v0[0], v0[1]); w.y = cvt_pk_bf16(v0[2], v0[3]); w.z = cvt_pk_bf16(v1[0], v1[1]); w.w = cvt_pk_bf16(v1[2], v1[3]);
                        *(u32x4*)(xb + o) = w;
                        if (RSS) {
#pragma unroll
                            for (int j = 0; j < 4; ++j) ss += v0[j] * v0[j] + v1[j] * v1[j];
                        }
                    }
                }
                if (RSS) { ss += __shfl_xor(ss, 16); ss += __shfl_xor(ss, 32); if (fq == 0) atomicAdd(rss + row, ss); }
            }
        }
    }
};

struct EpiSm {
    static constexpr bool PERM = true;
    bf16_t* P; LAS float* xl; const float* rss;
    __device__ __forceinline__ void operator()(Acc& acc, const Unit& u, int wr, int wc, int fr, int fq) const {
        const float sc0 = 0.044194173824159216f * 1.4426950408889634f;
        const int rl0 = wr * 64 + fr;
        const int rowg0 = u.pm * 256 + wr * 64 + fr;
#pragma unroll
        for (int ai = 0; ai < 2; ++ai)
#pragma unroll
            for (int m = 0; m < 4; ++m) {
                float mx = -3.0e38f;
#pragma unroll
                for (int bj = 0; bj < 2; ++bj)
#pragma unroll
                    for (int n = 0; n < 2; ++n)
#pragma unroll
                        for (int j = 0; j < 4; ++j) mx = fmaxf(mx, acc[ai][bj][m][n][j]);
                mx = fmaxf(mx, __shfl_xor(mx, 16)); mx = fmaxf(mx, __shfl_xor(mx, 32));
                if (fq == 0) xl[(rl0 + ai * 128 + m * 16) * 4 + wc] = mx;
            }
        asm volatile("s_waitcnt lgkmcnt(0)" ::: "memory"); __builtin_amdgcn_s_barrier(); asm volatile("" ::: "memory");
#pragma unroll
        for (int ai = 0; ai < 2; ++ai)
#pragma unroll
            for (int m = 0; m < 4; ++m) {
                const int rl = rl0 + ai * 128 + m * 16;
                const f32x4 mm = *(const LAS f32x4*)(xl + rl * 4);
                const float sc = sc0 * rsqrtf(rss[rowg0 + ai * 128 + m * 16] * (1.0f / D) + EPS);
                const float M = fmaxf(fmaxf(mm[0], mm[1]), fmaxf(mm[2], mm[3])) * sc;
                float sum = 0.f;
#pragma unroll
                for (int bj = 0; bj < 2; ++bj)
#pragma unroll
                    for (int n = 0; n < 2; ++n)
#pragma unroll
                        for (int j = 0; j < 4; ++j) { const float pv = exp2f(acc[ai][bj][m][n][j] * sc - M); acc[ai][bj][m][n][j] = pv; sum += pv; }
                sum += __shfl_xor(sum, 16); sum += __shfl_xor(sum, 32);
                if (fq == 0) xl[1024 + rl * 4 + wc] = sum;
            }
        asm volatile("s_waitcnt lgkmcnt(0)" ::: "memory"); __builtin_amdgcn_s_barrier(); asm volatile("" ::: "memory");
        const int row0 = u.pm * 256 + wr * 64 + fr, col0 = u.pn * 256 + wc * 32 + 8 * fq;
#pragma unroll
        for (int ai = 0; ai < 2; ++ai)
#pragma unroll
            for (int m = 0; m < 4; ++m) {
                const int rl = rl0 + ai * 128 + m * 16;
                const f32x4 ss = *(const LAS f32x4*)(xl + 1024 + rl * 4);
                const float inv = 1.0f / (ss[0] + ss[1] + ss[2] + ss[3]);
                bf16_t* rowp = P + (size_t)(row0 + ai * 128 + m * 16) * 1024 + col0;
#pragma unroll
                for (int bj = 0; bj < 2; ++bj) {
                    const f32x4 v0 = acc[ai][bj][m][0] * inv, v1 = acc[ai][bj][m][1] * inv;
                    u32x4 w; w.x = cvt_pk_bf16(v0[0], v0[1]); w.y = cvt_pk_bf16(v0[2], v0[3]); w.z = cvt_pk_bf16(v1[0], v1[1]); w.w = cvt_pk_bf16(v1[2], v1[3]);
                    *(u32x4*)(rowp + bj * 128) = w;
                }
            }
    }
};

struct EpiGu {
    static constexpr bool PERM = true;
    bf16_t* act; const float* rss; const float* cw; const float* cbias; float* gf; float* uf; float* gl;
    __device__ __forceinline__ void operator()(Acc& acc, const Unit& u, int wr, int wc, int fr, int fq) const {
        const int row0 = u.pm * 256 + wr * 64 + fr, c0 = u.pn * 128 + wc * 32 + 8 * fq;
#pragma unroll
        for (int ai = 0; ai < 2; ++ai) {
            float rs[4];
#pragma unroll
            for (int m = 0; m < 4; ++m) rs[m] = rsqrtf(rss[row0 + ai * 128 + m * 16] * (1.0f / D) + EPS);
            const int blk = u.pm * 4 + ai * 2 + wr;
            unsigned pk[4][4];
#pragma unroll
            for (int n = 0; n < 2; ++n) {
                const f32x4 w0 = *(const f32x4*)(cw + c0 + 4 * n), w1 = *(const f32x4*)(cw + FF + c0 + 4 * n), w2 = *(const f32x4*)(cw + 2 * FF + c0 + 4 * n), bb = *(const f32x4*)(cbias + c0 + 4 * n);
#pragma unroll
                for (int jp = 0; jp < 2; ++jp) {
                    const f32x2 w0p = {w0[2 * jp], w0[2 * jp + 1]}, w1p = {w1[2 * jp], w1[2 * jp + 1]}, w2p = {w2[2 * jp], w2[2 * jp + 1]}, bbp = {bb[2 * jp], bb[2 * jp + 1]};
                    f32x2 gm[4], r1[4], r2[4];
#pragma unroll
                    for (int m = 0; m < 4; ++m) {
                        gm[m] = (f32x2){acc[ai][0][m][n][2 * jp], acc[ai][0][m][n][2 * jp + 1]} * rs[m];
                        r1[m].x = __int_as_float(__builtin_amdgcn_update_dpp(0, __float_as_int(gm[m].x), 0x121, 0xF, 0xF, false));
                        r1[m].y = __int_as_float(__builtin_amdgcn_update_dpp(0, __float_as_int(gm[m].y), 0x121, 0xF, 0xF, false));
                        r2[m].x = __int_as_float(__builtin_amdgcn_update_dpp(0, __float_as_int(gm[m].x), 0x122, 0xF, 0xF, false));
                        r2[m].y = __int_as_float(__builtin_amdgcn_update_dpp(0, __float_as_int(gm[m].y), 0x122, 0xF, 0xF, false));
                    }
#pragma unroll
                    for (int m = 0; m < 4; ++m) {
                        const f32x2 q1 = m >= 1 ? r1[m >= 1 ? m - 1 : 0] : (f32x2){0.f, 0.f}, q2 = m >= 1 ? r2[m >= 1 ? m - 1 : 0] : (f32x2){0.f, 0.f};
                        f32x2 p1, p2;
                        p1.x = (fr >= 1) ? r1[m].x : q1.x; p1.y = (fr >= 1) ? r1[m].y : q1.y;
                        p2.x = (fr >= 2) ? r2[m].x : q2.x; p2.y = (fr >= 2) ? r2[m].y : q2.y;
                        const f32x2 a = w2p * gm[m] + (w1p * p1 + (w0p * p2 + bbp));
                        const f32x2 na = a * (-1.4426950408889634f);
                        f32x2 den; den.x = __builtin_amdgcn_exp2f(na.x); den.y = __builtin_amdgcn_exp2f(na.y);
                        den = den + 1.0f;
                        f32x2 rc; rc.x = __builtin_amdgcn_rcpf(den.x); rc.y = __builtin_amdgcn_rcpf(den.y);
                        const f32x2 up = (f32x2){acc[ai][1][m][n][2 * jp], acc[ai][1][m][n][2 * jp + 1]} * rs[m];
                        const f32x2 ov = (a * rc) * up;
                        pk[m][2 * n + jp] = cvt_pk_bf16(ov.x, ov.y);
                    }
                }
            }
#pragma unroll
            for (int m = 0; m < 4; ++m) {
                const size_t row = (size_t)(row0 + ai * 128 + m * 16);
                if (!(m == 0 && fr < 2)) { u32x4 w; w.x = pk[m][0]; w.y = pk[m][1]; w.z = pk[m][2]; w.w = pk[m][3]; *(u32x4*)(act + row * FF + c0) = w; }
            }
            if (fr < 2) {
                const size_t o = ((size_t)blk * 2 + fr) * FF + c0;
                *(f32x4*)(gf + o) = acc[ai][0][0][0] * rs[0]; *(f32x4*)(gf + o + 4) = acc[ai][0][0][1] * rs[0];
                *(f32x4*)(uf + o) = acc[ai][1][0][0] * rs[0]; *(f32x4*)(uf + o + 4) = acc[ai][1][0][1] * rs[0];
            }
            if (fr >= 14) {
                const size_t o = ((size_t)blk * 2 + (fr - 14)) * FF + c0;
                *(f32x4*)(gl + o) = acc[ai][0][3][0] * rs[3]; *(f32x4*)(gl + o + 4) = acc[ai][0][3][1] * rs[3];
            }
        }
    }
};
}

__device__ __forceinline__ void transpose_tile(const float* __restrict__ src, int K, int N, bf16_t* __restrict__ dst, const float* __restrict__ scale, int k0, int n0, int rowmode, LAS float* tl) {
    const int tid = threadIdx.x;
    const int r = tid >> 6, c4 = (tid & 63) * 4;
    f32x4 v[8];
#pragma unroll
    for (int i = 0; i < 8; ++i) v[i] = __builtin_nontemporal_load((const f32x4*)(src + (size_t)(k0 + r + 8 * i) * N + n0 + c4));
#pragma unroll
    for (int i = 0; i < 8; ++i) {
        const int k = r + 8 * i;
        const float s = scale ? scale[k0 + k] : 1.0f;
        tl[k * 257 + c4 + 0] = v[i][0] * s; tl[k * 257 + c4 + 1] = v[i][1] * s; tl[k * 257 + c4 + 2] = v[i][2] * s; tl[k * 257 + c4 + 3] = v[i][3] * s;
    }
    __syncthreads();
    const int kg = (tid & 7) * 8;
#pragma unroll
    for (int q = 0; q < 4; ++q) {
        const int n = (tid >> 3) + 64 * q;
        float f[8];
#pragma unroll
        for (int j = 0; j < 8; ++j) f[j] = tl[(kg + j) * 257 + n];
        const int c = n0 + n;
        const int drow = rowmode == 0 ? c : (256 * (c >> 7) + (c & 127) + (rowmode == 2 ? 128 : 0));
        u32x4 w; w.x = cvt_pk_bf16(f[0], f[1]); w.y = cvt_pk_bf16(f[2], f[3]); w.z = cvt_pk_bf16(f[4], f[5]); w.w = cvt_pk_bf16(f[6], f[7]);
        *(u32x4*)(dst + (size_t)drow * K + k0 + kg) = w;
    }
    __syncthreads();
}

__device__ __forceinline__ void convert_tile(const float* __restrict__ src, int N, bf16_t* __restrict__ dst, const float* __restrict__ scale, int k0, int n0) {
    const int tid = threadIdx.x, r = tid >> 6, c4 = (tid & 63) * 4;
    f32x4 v[8];
#pragma unroll
    for (int i = 0; i < 8; ++i) v[i] = __builtin_nontemporal_load((const f32x4*)(src + (size_t)(k0 + r + 8 * i) * N + n0 + c4));
#pragma unroll
    for (int i = 0; i < 8; ++i) {
        const int k = k0 + r + 8 * i;
        const float sc = scale[k];
        u32x2 o; o.x = cvt_pk_bf16(v[i][0] * sc, v[i][1] * sc); o.y = cvt_pk_bf16(v[i][2] * sc, v[i][3] * sc);
        *(u32x2*)(dst + (size_t)k * N + n0 + c4) = o;
    }
}

__device__ __forceinline__ void rmsnorm_row_bf16(const float* __restrict__ src, const float* __restrict__ w, bf16_t* __restrict__ dst, int lane) {
    f32x4 v[8]; float ss = 0.f;
#pragma unroll
    for (int i = 0; i < 8; ++i) { v[i] = __builtin_nontemporal_load((const f32x4*)(src + i * 256 + lane * 4)); ss += v[i][0] * v[i][0] + v[i][1] * v[i][1] + v[i][2] * v[i][2] + v[i][3] * v[i][3]; }
    ss = wave_sum(ss);
    const float rstd = rsqrtf(ss * (1.0f / D) + EPS);
#pragma unroll
    for (int i = 0; i < 8; ++i) {
        const f32x4 g = *(const f32x4*)(w + i * 256 + lane * 4);
        u32x2 o; o.x = cvt_pk_bf16(v[i][0] * rstd * g[0], v[i][1] * rstd * g[1]); o.y = cvt_pk_bf16(v[i][2] * rstd * g[2], v[i][3] * rstd * g[3]);
        *(u32x2*)(dst + i * 256 + lane * 4) = o;
    }
}

__device__ void phase_prep(const Params& p, LAS unsigned char* lds) {
    const int tid = threadIdx.x, lane = tid & 63, w = tid >> 6;
    unsigned char* ws = p.ws;
    for (int t = blockIdx.x; t < 896 + 5 * 256; t += gridDim.x) {
        if (t < 896) { const int tk = t / 28, tn = t % 28; transpose_tile(p.w_in, D, INC, (bf16_t*)(ws + WS_WIN), nullptr, tk * 64, tn * 256, 0, (LAS float*)lds); }
        else { const int q = (t - 896) >> 8, r = (t - 896) & 255, tk = r >> 3, tn = r & 7;
            const float* src = q == 0 ? p.w_out : q == 1 ? p.wq : q == 2 ? p.wk : q == 3 ? p.wv : p.wo;
            const size_t off = q == 0 ? WS_WOUT : q == 1 ? WS_WQ : q == 2 ? WS_WK : q == 3 ? WS_WV : WS_WO;
            if (q == 1) convert_tile(src, D, (bf16_t*)(ws + off), p.norm2_w, tk * 64, tn * 256);
            else transpose_tile(src, D, D, (bf16_t*)(ws + off), nullptr, tk * 64, tn * 256, 0, (LAS float*)lds); }
    }
    for (int r = blockIdx.x * 8 + w; r < T + 1024; r += gridDim.x * 8) {
        if (r < T) rmsnorm_row_bf16(p.x + (size_t)r * D, p.norm1_w, (bf16_t*)(ws + WS_H) + (size_t)r * D, lane);
        else rmsnorm_row_bf16(p.mem + (size_t)(r - T) * D, p.mem_norm_w, (bf16_t*)(ws + WS_MEMN) + (size_t)(r - T) * D, lane);
    }
    for (int i = blockIdx.x * 512 + tid; i < 2 * T; i += gridDim.x * 512) ((float*)(ws + WS_RSS2))[i] = 0.f;
    for (int i = blockIdx.x * 512 + tid; i < 1024; i += gridDim.x * 512) { const float a0 = p.hgrn_lb[i], a1 = p.hgrn_lb[1024 + i]; ((float*)(ws + WS_LB))[i] = 1.0f / (1.0f + __expf(a1 - a0)); }
}

__device__ void phase_ffn_weights(const Params& p, LAS unsigned char* lds) {
    unsigned char* ws = p.ws;
    for (int t = blockIdx.x; t < 3 * 704; t += gridDim.x) {
        const int q = t / 704, r = t % 704;
        if (q < 2) { const int tk = r / 22, tn = r % 22; transpose_tile(q == 0 ? p.w_gate : p.w_up, D, FF, (bf16_t*)(ws + WS_WGU), p.norm3_w, tk * 64, tn * 256, 1 + q, (LAS float*)lds); }
        else { const int tk = r >> 3, tn = r & 7; transpose_tile(p.w_down, FF, D, (bf16_t*)(ws + WS_WDN), nullptr, tk * 64, tn * 256, 0, (LAS float*)lds); }
    }
}

#define LDS_BARRIER() do { asm volatile("s_waitcnt lgkmcnt(0)" ::: "memory"); __builtin_amdgcn_s_barrier(); asm volatile("" ::: "memory"); } while (0)
__device__ __forceinline__ int hgrn_item_of(int slot, bool deal) {
    if (!deal) { const int item = blockIdx.x + slot * gridDim.x; return item < 4096 ? item : -1; }
    const int c = blockIdx.x;
    if (c < 64) return slot < 3 ? c + 256 * slot : -1;
    if (slot < 16) return c + 256 * slot;
    if (slot >= 21) return -1;
    const int r = (slot - 16) * 192 + (c - 64);
    return r < 832 ? (3 + (r >> 6)) * 256 + (r & 63) : -1;
}

__device__ void phase_hgrn_local(const Params& p, LAS unsigned char* lds) {
    const int tid = threadIdx.x, lane = tid & 63, w = tid >> 6, fr = lane & 15, fq = lane >> 4;
    LAS bf16_t* Ak = (LAS bf16_t*)(lds);
    LAS bf16_t* Vt = (LAS bf16_t*)(lds + 18432);
    LAS float* tots = (LAS float*)(lds + 36864);
    const float* logf = (const float*)(p.ws + WS_LOGF);
    const bf16_t* proj = (const bf16_t*)(p.ws + WS_B0);
    bf16_t* us = (bf16_t*)(p.ws + WS_US);
    float* dec = (float*)(p.ws + WS_DEC);
    const bool deal = (gridDim.x == 256);
    const int kp = lane, sg = w;
    f32x2 c[8]; unsigned vv[8];
#define HL_LOAD(ITEM) do { const int _it = (ITEM); const int _bh = _it >> 7, _n = _it & 127, _b = _bh >> 3, _h = _bh & 7; const size_t _t0 = (size_t)_b * SEQ + (size_t)_n * 64; \
        _Pragma("unroll") for (int i = 0; i < 8; ++i) { c[i] = __builtin_nontemporal_load((const f32x2*)(logf + (_t0 + 8 * sg + i) * 1024 + _h * 128 + 2 * kp)); vv[i] = __builtin_nontemporal_load((const unsigned*)(proj + (_t0 + 8 * sg + i) * PJ + 1024 + _h * 128 + 2 * kp)); } } while (0)
    int item = hgrn_item_of(0, deal);
    if (item >= 0) HL_LOAD(item);
    for (int slot = 0; item >= 0; ++slot) {
        const int nitem = hgrn_item_of(slot + 1, deal);
        f32x2 kk[8];
#pragma unroll
        for (int i = 0; i < 8; ++i) { kk[i].x = 1.0f - __expf(c[i].x); kk[i].y = 1.0f - __expf(c[i].y); }
#pragma unroll
        for (int i = 1; i < 8; ++i) c[i] += c[i - 1];
        *(LAS f32x2*)(tots + sg * 128 + 2 * kp) = c[7];
        LDS_BARRIER();
        f32x2 off = {0.f, 0.f}, tot = {0.f, 0.f};
#pragma unroll
        for (int g = 0; g < 8; ++g) { const f32x2 tv = *(const LAS f32x2*)(tots + g * 128 + 2 * kp); if (g < sg) off += tv; tot += tv; }
        float e0[8], e1[8];
#pragma unroll
        for (int i = 0; i < 8; ++i) { e0[i] = kk[i].x * __expf(tot.x - off.x - c[i].x); e1[i] = kk[i].y * __expf(tot.y - off.y - c[i].y); }
        u32x4 a0, a1, v0, v1;
        a0.x = cvt_pk_bf16(e0[0], e0[1]); a0.y = cvt_pk_bf16(e0[2], e0[3]); a0.z = cvt_pk_bf16(e0[4], e0[5]); a0.w = cvt_pk_bf16(e0[6], e0[7]);
        a1.x = cvt_pk_bf16(e1[0], e1[1]); a1.y = cvt_pk_bf16(e1[2], e1[3]); a1.z = cvt_pk_bf16(e1[4], e1[5]); a1.w = cvt_pk_bf16(e1[6], e1[7]);
        v0.x = (vv[0] & 0xffffu) | (vv[1] << 16); v0.y = (vv[2] & 0xffffu) | (vv[3] << 16); v0.z = (vv[4] & 0xffffu) | (vv[5] << 16); v0.w = (vv[6] & 0xffffu) | (vv[7] << 16);
        v1.x = (vv[0] >> 16) | (vv[1] & 0xffff0000u); v1.y = (vv[2] >> 16) | (vv[3] & 0xffff0000u); v1.z = (vv[4] >> 16) | (vv[5] & 0xffff0000u); v1.w = (vv[6] >> 16) | (vv[7] & 0xffff0000u);
        *(LAS u32x4*)(Ak + (2 * kp) * 72 + 8 * sg) = a0; *(LAS u32x4*)(Ak + (2 * kp + 1) * 72 + 8 * sg) = a1;
        *(LAS u32x4*)(Vt + (2 * kp) * 72 + 8 * sg) = v0; *(LAS u32x4*)(Vt + (2 * kp + 1) * 72 + 8 * sg) = v1;
        if (sg == 0) { f32x2 d; d.x = __expf(tot.x); d.y = __expf(tot.y); *(f32x2*)(dec + (size_t)item * 128 + 2 * kp) = d; }
        if (nitem >= 0) HL_LOAD(nitem);
        LDS_BARRIER();
        f32x4 acc[8];
#pragma unroll
        for (int kt = 0; kt < 8; ++kt) acc[kt] = (f32x4){0.f, 0.f, 0.f, 0.f};
#pragma unroll
        for (int ks = 0; ks < 2; ++ks) {
            const bf16x8 bq = *(const LAS bf16x8*)(Vt + (16 * w + fr) * 72 + 32 * ks + 8 * fq);
#pragma unroll
            for (int kt = 0; kt < 8; ++kt) { const bf16x8 a = *(const LAS bf16x8*)(Ak + (16 * kt + fr) * 72 + 32 * ks + 8 * fq); acc[kt] = __builtin_amdgcn_mfma_f32_16x16x32_bf16(a, bq, acc[kt], 0, 0, 0); }
        }
        bf16_t* dst = us + (size_t)item * 16384 + (16 * w + fr) * 128 + 4 * fq;
#pragma unroll
        for (int kt = 0; kt < 8; ++kt) { u32x2 o; o.x = cvt_pk_bf16_c(acc[kt][0], acc[kt][1]); o.y = cvt_pk_bf16_c(acc[kt][2], acc[kt][3]); *(u32x2*)(dst + 16 * kt) = o; }
        LDS_BARRIER();
        item = nitem;
    }
#undef HL_LOAD
}

__device__ void phase_hgrn_scan(const Params& p) {
    const bf16_t* us = (const bf16_t*)(p.ws + WS_US);
    bf16_t* sb = (bf16_t*)p.out;
    const float* dec = (const float*)(p.ws + WS_DEC);
    for (int idx = blockIdx.x * 512 + threadIdx.x; idx < 32 * 4096; idx += gridDim.x * 512) {
        const int bh = idx >> 12, e = (idx & 4095) * 4, k = e & 127;
        const bf16_t* base = us + (size_t)bh * 128 * 16384 + e;
        bf16_t* obase = sb + (size_t)bh * 128 * 16384 + e;
        const float* dbase = dec + (size_t)bh * 128 * 128 + k;
        f32x4 s = {0.f, 0.f, 0.f, 0.f};
        for (int n0 = 0; n0 < 128; n0 += 8) {
            u32x2 uu[8]; f32x4 dd[8];
#pragma unroll
            for (int i = 0; i < 8; ++i) { uu[i] = __builtin_nontemporal_load((const u32x2*)(base + (size_t)(n0 + i) * 16384)); dd[i] = *(const f32x4*)(dbase + (n0 + i) * 128); }
#pragma unroll
            for (int i = 0; i < 8; ++i) {
                u32x2 o; o.x = cvt_pk_bf16(s[0], s[1]); o.y = cvt_pk_bf16(s[2], s[3]);
                *(u32x2*)(obase + (size_t)(n0 + i) * 16384) = o;
                const f32x4 u4 = {bf_lo(uu[i].x), bf_hi(uu[i].x), bf_lo(uu[i].y), bf_hi(uu[i].y)};
                s = s * dd[i] + u4;
            }
        }
    }
}

__device__ void phase_hgrn_out(const Params& p, LAS unsigned char* lds) {
    const int tid = threadIdx.x, lane = tid & 63, w = tid >> 6, fr = lane & 15, fq = lane >> 4;
    LAS bf16_t* Qe = (LAS bf16_t*)(lds);
    LAS bf16_t* Ke = (LAS bf16_t*)(lds + 17408);
    LAS bf16_t* St = (LAS bf16_t*)(lds + 34816);
    LAS bf16_t* Vt = (LAS bf16_t*)(lds + 69632);
    LAS bf16_t* Pm = (LAS bf16_t*)(lds + 88064);
    LAS float* tots = (LAS float*)(lds + 97280);
    LAS float* ssq = (LAS float*)(lds + 101376);
    const float* logf = (const float*)(p.ws + WS_LOGF);
    const bf16_t* proj = (const bf16_t*)(p.ws + WS_B0);
    const bf16_t* us = (const bf16_t*)p.out;
    bf16_t* mix = (bf16_t*)(p.ws + WS_H);
    const int kp = lane, sg = w;
    f32x2 c[8]; unsigned vv[8], qv[8]; u32x2 sv[8];
#define HG_LOAD_PRE(ITEM) do { const int _it = (ITEM); const int _bh = _it >> 7, _n = _it & 127, _b = _bh >> 3, _h = _bh & 7; const size_t _t0 = (size_t)_b * SEQ + (size_t)_n * 64; \
        _Pragma("unroll") for (int i = 0; i < 8; ++i) { const size_t t = _t0 + 8 * sg + i; \
            c[i] = __builtin_nontemporal_load((const f32x2*)(logf + t * 1024 + _h * 128 + 2 * kp)); qv[i] = __builtin_nontemporal_load((const unsigned*)(proj + t * PJ + _h * 128 + 2 * kp)); vv[i] = __builtin_nontemporal_load((const unsigned*)(proj + t * PJ + 1024 + _h * 128 + 2 * kp)); } \
        _Pragma("unroll") for (int i = 0; i < 8; ++i) { const int idx = tid + 512 * i; sv[i] = __builtin_nontemporal_load((const u32x2*)(us + (size_t)_it * 16384 + (idx >> 5) * 128 + (idx & 31) * 4)); } } while (0)
    if ((int)blockIdx.x < 4096) HG_LOAD_PRE(blockIdx.x);
    for (int item = blockIdx.x; item < 4096; item += gridDim.x) {
        const int bh = item >> 7, n = item & 127, b = bh >> 3, h = bh & 7;
        const size_t t0 = (size_t)b * SEQ + (size_t)n * 64;
        f32x2 kk[8];
#pragma unroll
        for (int i = 0; i < 8; ++i) { kk[i].x = 1.0f - __expf(c[i].x); kk[i].y = 1.0f - __expf(c[i].y); }
#pragma unroll
        for (int i = 1; i < 8; ++i) c[i] += c[i - 1];
        *(LAS f32x2*)(tots + sg * 128 + 2 * kp) = c[7];
        LDS_BARRIER();
        f32x2 off = {0.f, 0.f}, tot = {0.f, 0.f};
#pragma unroll
        for (int g = 0; g < 8; ++g) { const f32x2 tv = *(const LAS f32x2*)(tots + g * 128 + 2 * kp); if (g < sg) off += tv; tot += tv; }
        const f32x2 ref = tot * 0.5f;
#pragma unroll
        for (int i = 0; i < 8; ++i) {
            const float bx = off.x + c[i].x - ref.x, by = off.y + c[i].y - ref.y;
            const int t = 8 * sg + i;
            *(LAS unsigned*)(Qe + t * 136 + 2 * kp) = cvt_pk_bf16(bf_lo(qv[i]) * __expf(bx), bf_hi(qv[i]) * __expf(by));
            *(LAS unsigned*)(Ke + t * 136 + 2 * kp) = cvt_pk_bf16(kk[i].x * __expf(-bx), kk[i].y * __expf(-by));
        }
        {
            u32x4 v0, v1;
            v0.x = (vv[0] & 0xffffu) | (vv[1] << 16); v0.y = (vv[2] & 0xffffu) | (vv[3] << 16); v0.z = (vv[4] & 0xffffu) | (vv[5] << 16); v0.w = (vv[6] & 0xffffu) | (vv[7] << 16);
            v1.x = (vv[0] >> 16) | (vv[1] & 0xffff0000u); v1.y = (vv[2] >> 16) | (vv[3] & 0xffff0000u); v1.z = (vv[4] >> 16) | (vv[5] & 0xffff0000u); v1.w = (vv[6] >> 16) | (vv[7] & 0xffff0000u);
            *(LAS u32x4*)(Vt + (2 * kp) * 72 + 8 * sg) = v0; *(LAS u32x4*)(Vt + (2 * kp + 1) * 72 + 8 * sg) = v1;
        }
        {
            const int k4 = (tid & 31) * 4;
            f32x4 tt = {0.f, 0.f, 0.f, 0.f};
#pragma unroll
            for (int g = 0; g < 8; ++g) tt += *(const LAS f32x4*)(tots + g * 128 + k4);
            const f32x4 er = {__expf(0.5f * tt[0]), __expf(0.5f * tt[1]), __expf(0.5f * tt[2]), __expf(0.5f * tt[3])};
#pragma unroll
            for (int i = 0; i < 8; ++i) {
                const int v = (tid >> 5) + 16 * i;
                u32x2 o; o.x = cvt_pk_bf16(bf_lo(sv[i].x) * er[0], bf_hi(sv[i].x) * er[1]); o.y = cvt_pk_bf16(bf_lo(sv[i].y) * er[2], bf_hi(sv[i].y) * er[3]);
                *(LAS u32x2*)(St + v * 136 + k4) = o;
            }
        }
        const int tb = w >> 1, hf = w & 1, tl = 16 * tb + fr;
        u32x2 gg[4];
#pragma unroll
        for (int i = 0; i < 4; ++i) gg[i] = __builtin_nontemporal_load((const u32x2*)(proj + (t0 + tl) * PJ + 2048 + h * 128 + 16 * (4 * hf + i) + 4 * fq));
        const int cc_ = h * 128 + (tid & 31) * 4, tr = tid >> 5;
        u32x2 za[6], zb[6], cbv[4];
#pragma unroll
        for (int r = 0; r < 6; ++r) {
            const int tt = 4 * tr + r - 2;
            if (tt < 0 && n == 0) { za[r] = (u32x2){0u, 0u}; zb[r] = (u32x2){0u, 0u}; }
            else { const bf16_t* rp = proj + (size_t)((long)t0 + tt) * PJ; za[r] = __builtin_nontemporal_load((const u32x2*)(rp + 4096 + cc_)); zb[r] = __builtin_nontemporal_load((const u32x2*)(rp + 5120 + cc_)); }
        }
#pragma unroll
        for (int i = 0; i < 4; ++i) cbv[i] = __builtin_nontemporal_load((const u32x2*)(proj + (t0 + 4 * tr + i) * PJ + 3072 + cc_));
        if (item + (int)gridDim.x < 4096) HG_LOAD_PRE(item + (int)gridDim.x);
        LDS_BARRIER();
#pragma unroll
        for (int s2 = 0; s2 < 2; ++s2) {
            const int st = 2 * hf + s2;
            f32x4 a4 = {0.f, 0.f, 0.f, 0.f};
            if (st <= tb) {
#pragma unroll
                for (int ks = 0; ks < 4; ++ks) {
                    const bf16x8 a = *(const LAS bf16x8*)(Ke + (16 * st + fr) * 136 + 32 * ks + 8 * fq);
                    const bf16x8 bq = *(const LAS bf16x8*)(Qe + tl * 136 + 32 * ks + 8 * fq);
                    a4 = __builtin_amdgcn_mfma_f32_16x16x32_bf16(a, bq, a4, 0, 0, 0);
                }
            }
            const int s0 = 16 * st + 4 * fq;
            u32x2 o; o.x = cvt_pk_bf16(s0 + 0 <= tl ? a4[0] : 0.f, s0 + 1 <= tl ? a4[1] : 0.f); o.y = cvt_pk_bf16(s0 + 2 <= tl ? a4[2] : 0.f, s0 + 3 <= tl ? a4[3] : 0.f);
            *(LAS u32x2*)(Pm + tl * 72 + s0) = o;
        }
        LDS_BARRIER();
        f32x4 ao[4];
#pragma unroll
        for (int i = 0; i < 4; ++i) ao[i] = (f32x4){0.f, 0.f, 0.f, 0.f};
#pragma unroll
        for (int ks = 0; ks < 4; ++ks) {
            const bf16x8 bq = *(const LAS bf16x8*)(Qe + tl * 136 + 32 * ks + 8 * fq);
#pragma unroll
            for (int i = 0; i < 4; ++i) { const bf16x8 a = *(const LAS bf16x8*)(St + (16 * (4 * hf + i) + fr) * 136 + 32 * ks + 8 * fq); ao[i] = __builtin_amdgcn_mfma_f32_16x16x32_bf16(a, bq, ao[i], 0, 0, 0); }
        }
#pragma unroll
        for (int ks = 0; ks < 2; ++ks) {
            const bf16x8 bq = *(const LAS bf16x8*)(Pm + tl * 72 + 32 * ks + 8 * fq);
#pragma unroll
            for (int i = 0; i < 4; ++i) { const bf16x8 a = *(const LAS bf16x8*)(Vt + (16 * (4 * hf + i) + fr) * 72 + 32 * ks + 8 * fq); ao[i] = __builtin_amdgcn_mfma_f32_16x16x32_bf16(a, bq, ao[i], 0, 0, 0); }
        }
        float ss = 0.f;
#pragma unroll
        for (int i = 0; i < 4; ++i)
#pragma unroll
            for (int j = 0; j < 4; ++j) ss += ao[i][j] * ao[i][j];
        ss += __shfl_xor(ss, 16); ss += __shfl_xor(ss, 32);
        if (fq == 0) ssq[tl * 2 + hf] = ss;
        LDS_BARRIER();
        const float rstd = rsqrtf((ssq[tl * 2] + ssq[tl * 2 + 1]) * (1.0f / 128.0f) + EPS);
#pragma unroll
        for (int i = 0; i < 4; ++i) {
            const int v0 = 16 * (4 * hf + i) + 4 * fq;
            const f32x4 nw = *(const f32x4*)(p.hgrn_norm_w + v0);
            u32x2 o;
            o.x = cvt_pk_bf16(ao[i][0] * rstd * nw[0] * silu_f(bf_lo(gg[i].x)), ao[i][1] * rstd * nw[1] * silu_f(bf_hi(gg[i].x)));
            o.y = cvt_pk_bf16(ao[i][2] * rstd * nw[2] * silu_f(bf_lo(gg[i].y)), ao[i][3] * rstd * nw[3] * silu_f(bf_hi(gg[i].y)));
            *(u32x2*)(mix + (t0 + tl) * D + h * 128 + v0) = o;
        }
        {
            const f32x4 w0 = *(const f32x4*)(p.sconv_w + cc_), w1 = *(const f32x4*)(p.sconv_w + 1024 + cc_), w2 = *(const f32x4*)(p.sconv_w + 2048 + cc_);
            f32x4 z[6];
#pragma unroll
            for (int r = 0; r < 6; ++r) z[r] = (f32x4){bf_lo(za[r].x) * bf_lo(zb[r].x), bf_hi(za[r].x) * bf_hi(zb[r].x), bf_lo(za[r].y) * bf_lo(zb[r].y), bf_hi(za[r].y) * bf_hi(zb[r].y)};
#pragma unroll
            for (int i = 0; i < 4; ++i) {
                const size_t t = t0 + 4 * tr + i;
                const f32x4 y = w0 * z[i] + w1 * z[i + 1] + w2 * z[i + 2];
                u32x2 o; o.x = cvt_pk_bf16(bf_lo(cbv[i].x) * y[0], bf_hi(cbv[i].x) * y[1]); o.y = cvt_pk_bf16(bf_lo(cbv[i].y) * y[2], bf_hi(cbv[i].y) * y[3]);
                *(u32x2*)(mix + t * D + 1024 + cc_) = o;
            }
        }
        LDS_BARRIER();
    }
#undef HG_LOAD_PRE
}

__device__ void phase_fixup(const Params& p) {
    const float* gf = (const float*)(p.ws + WS_GF); const float* uf = (const float*)(p.ws + WS_UF); const float* gl = (const float*)(p.ws + WS_GL);
    bf16_t* act = (bf16_t*)(p.ws + WS_ACT);
    const int per = FF / 4;
    for (int idx = blockIdx.x * 512 + threadIdx.x; idx < 512 * 2 * per; idx += gridDim.x * 512) {
        const int c = (idx % per) * 4, br = idx / per, r = br & 1, blk = br >> 1;
        const bool first = (blk & 127) == 0;
        const f32x4 zero = {0.f, 0.f, 0.f, 0.f};
        const f32x4 g0 = __builtin_nontemporal_load((const f32x4*)(gf + ((size_t)blk * 2 + r) * FF + c));
        f32x4 g1, g2;
        if (r == 0) { g1 = first ? zero : *(const f32x4*)(gl + ((size_t)(blk - 1) * 2 + 1) * FF + c); g2 = first ? zero : *(const f32x4*)(gl + ((size_t)(blk - 1) * 2) * FF + c); }
        else { g1 = *(const f32x4*)(gf + ((size_t)blk * 2) * FF + c); g2 = first ? zero : *(const f32x4*)(gl + ((size_t)(blk - 1) * 2 + 1) * FF + c); }
        const f32x4 uu = __builtin_nontemporal_load((const f32x4*)(uf + ((size_t)blk * 2 + r) * FF + c));
        const f32x4 w0 = *(const f32x4*)(p.ffn_conv_w + c), w1 = *(const f32x4*)(p.ffn_conv_w + FF + c), w2 = *(const f32x4*)(p.ffn_conv_w + 2 * FF + c), bb = *(const f32x4*)(p.ffn_conv_b + c);
        const f32x4 a = w2 * g0 + w1 * g1 + w0 * g2 + bb;
        u32x2 o; o.x = cvt_pk_bf16(silu_f(a[0]) * uu[0], silu_f(a[1]) * uu[1]); o.y = cvt_pk_bf16(silu_f(a[2]) * uu[2], silu_f(a[3]) * uu[3]);
        *(u32x2*)(act + ((size_t)blk * 64 + r) * FF + c) = o;
    }
}

__device__ void phase_final(const Params& p) {
    const int lane = threadIdx.x & 63, w = threadIdx.x >> 6;
    const bf16_t* x3 = (const bf16_t*)(p.ws + WS_B0);
    for (int r = blockIdx.x * 8 + w; r < T; r += gridDim.x * 8) {
        const bf16_t* src = x3 + (size_t)r * D;
        float* row = p.out + (size_t)r * D;
        u32x4 v[4]; float ss = 0.f;
#pragma unroll
        for (int i = 0; i < 4; ++i) {
            v[i] = __builtin_nontemporal_load((const u32x4*)(src + i * 512 + lane * 8));
            const float a0 = bf_lo(v[i].x), a1 = bf_hi(v[i].x), a2 = bf_lo(v[i].y), a3 = bf_hi(v[i].y), a4 = bf_lo(v[i].z), a5 = bf_hi(v[i].z), a6 = bf_lo(v[i].w), a7 = bf_hi(v[i].w);
            ss += a0 * a0 + a1 * a1 + a2 * a2 + a3 * a3 + a4 * a4 + a5 * a5 + a6 * a6 + a7 * a7;
        }
        ss = wave_sum(ss);
        const float rstd = rsqrtf(ss * (1.0f / D) + EPS);
#pragma unroll
        for (int i = 0; i < 4; ++i) {
            const f32x4 g0 = *(const f32x4*)(p.final_norm_w + i * 512 + lane * 8), g1 = *(const f32x4*)(p.final_norm_w + i * 512 + lane * 8 + 4);
            f32x4 o0 = {bf_lo(v[i].x), bf_hi(v[i].x), bf_lo(v[i].y), bf_hi(v[i].y)}, o1 = {bf_lo(v[i].z), bf_hi(v[i].z), bf_lo(v[i].w), bf_hi(v[i].w)};
            __builtin_nontemporal_store(o0 * rstd * g0, (f32x4*)(row + i * 512 + lane * 8)); __builtin_nontemporal_store(o1 * rstd * g1, (f32x4*)(row + i * 512 + lane * 8 + 4));
        }
    }
}

#define XB_TMO      128
#define XB_XCNT(j)  (256  + 64 * (j))
#define XB_XSUB(j)  (1280 + 64 * (j))
#define XB_XGEN(j)  (2304 + 64 * (j))
#define XB_TOP      3328
#define XB_TOPGEN   3392
#define XCD_BAR_WORDS 3456
#define XB_SPIN_CAP (1u << 21)
__device__ __forceinline__ unsigned xb_ld(unsigned* p)              { return __hip_atomic_load(p, __ATOMIC_RELAXED, __HIP_MEMORY_SCOPE_AGENT); }
__device__ __forceinline__ unsigned xb_add(unsigned* p, unsigned v) { return __hip_atomic_fetch_add(p, v, __ATOMIC_RELAXED, __HIP_MEMORY_SCOPE_AGENT); }
__device__ __forceinline__ unsigned xb_xcc_id() { return (unsigned)__builtin_amdgcn_s_getreg((3 << 11) | 20) & 0xFu; }
#define XB_SPIN(cond, bar) do { unsigned _sp = 0; while (cond) { __builtin_amdgcn_s_sleep(1); \
    if ((++_sp & 255u) == 0u) { if (xb_ld(&(bar)[XB_TMO])) break; if (_sp > XB_SPIN_CAP) { atomicAdd(&(bar)[XB_TMO], 1u); break; } } } } while (0)
struct XcdBarrier { unsigned* bar; unsigned x; volatile LAS unsigned* st; };
__device__ __forceinline__ XcdBarrier xcd_barrier_post(unsigned* bar, volatile LAS unsigned* st) {
    XcdBarrier b; b.bar = bar; b.x = xb_xcc_id(); b.st = st;
    if (threadIdx.x == 0) (void)xb_add(&bar[XB_XCNT(b.x)], 1u);
    return b;
}
__device__ __forceinline__ void xcd_barrier_complete(unsigned* bar, unsigned x, unsigned& nloc, unsigned& nx) {
    const unsigned G = gridDim.x * gridDim.y * gridDim.z;
    unsigned sum, cnt, mine, sp = 0u;
    for (;;) {
        sum = 0u; cnt = 0u; mine = 0u;
#pragma unroll
        for (unsigned j = 0; j < 16; ++j) { const unsigned c = xb_ld(&bar[XB_XCNT(j)]); sum += c; cnt += (c > 0u) ? 1u : 0u; mine = (j == x) ? c : mine; }
        if (sum == G) break;
        __builtin_amdgcn_s_sleep(1);
        if ((++sp & 255u) == 0u) { if (xb_ld(&bar[XB_TMO])) break; if (sp > XB_SPIN_CAP) { atomicAdd(&bar[XB_TMO], 1u); break; } }
    }
    nloc = mine > 0u ? mine : 1u; nx = cnt > 0u ? cnt : 1u;
}
__device__ __forceinline__ void xcd_barrier(const XcdBarrier& b) {
    asm volatile("s_waitcnt vmcnt(0)" ::: "memory");
    __syncthreads();
    if (threadIdx.x == 0) {
        unsigned* bar = b.bar;
        __builtin_amdgcn_s_waitcnt(0);
        unsigned nloc = b.st[0], nx = b.st[1];
        if (nloc == 0u) { xcd_barrier_complete(bar, b.x, nloc, nx); b.st[0] = nloc; b.st[1] = nx; }
        const unsigned old = xb_add(&bar[XB_XSUB(b.x)], 1u);
        const unsigned gen = old / nloc;
        if (old + 1u == (gen + 1u) * nloc) {
            __builtin_amdgcn_fence(__ATOMIC_RELEASE, "agent");
            asm volatile("s_waitcnt vmcnt(0)" ::: "memory");
            const unsigned og = xb_add(&bar[XB_TOP], 1u);
            const unsigned tg = og / nx;
            if (og + 1u == (tg + 1u) * nx) xb_add(&bar[XB_TOPGEN], 1u);
            else XB_SPIN(xb_ld(&bar[XB_TOPGEN]) == tg, bar);
            __builtin_amdgcn_fence(__ATOMIC_ACQUIRE, "agent");
            xb_add(&bar[XB_XGEN(b.x)], 1u);
            asm volatile("s_waitcnt vmcnt(0)" ::: "memory");
        } else {
            XB_SPIN(xb_ld(&bar[XB_XGEN(b.x)]) == gen, bar);
            __builtin_amdgcn_fence(__ATOMIC_ACQUIRE, "agent");
            asm volatile("s_waitcnt vmcnt(0)" ::: "memory");
        }
    }
    __syncthreads();
}

__global__ void __launch_bounds__(512) fwd_megakernel(Params p) {
    extern __shared__ __attribute__((aligned(16))) unsigned char smem[];
    LAS unsigned char* lds = (LAS unsigned char*)smem;
    unsigned char* ws = p.ws;
    bf16_t* const H = (bf16_t*)(ws + WS_H); bf16_t* const B0 = (bf16_t*)(ws + WS_B0); bf16_t* const B1 = (bf16_t*)(ws + WS_B1); bf16_t* const B2 = (bf16_t*)(ws + WS_B2);
    float* const rss2 = (float*)(ws + WS_RSS2); float* const rss3 = (float*)(ws + WS_RSS3);
#define RUN(k) (PH_ON(k) && p.ph_lo <= (k) && (k) <= p.ph_hi)
    volatile LAS unsigned* stw = (volatile LAS unsigned*)(lds + STAGE_BYTES + 8192);
    if (threadIdx.x < 4) stw[threadIdx.x] = 0u;
    __syncthreads();
    XcdBarrier xbar; xbar.bar = (unsigned*)(ws + WS_BAR); xbar.x = 0u; xbar.st = stw;
    if (p.ph_lo < p.ph_hi) xbar = xcd_barrier_post((unsigned*)(ws + WS_BAR), stw);
    if (p.ph_hi > 1000) cg::this_grid().sync();
#define SEAM(k) do { if (p.ph_lo <= (k) && (k) < p.ph_hi) xcd_barrier(xbar); } while (0)
    if (RUN(0)) { phase_prep(p, lds); }
    SEAM(0);
    if (RUN(1)) {
        { pg8::Gemm g{H, (const bf16_t*)(ws + WS_WIN), D, D, D}; pg8::Order S; S.init(T / 256, INC / 256, 0, D, D);
          pg8::EpiIn E{B0, (float*)(ws + WS_LOGF), (const float*)(ws + WS_LB)}; pg8::gemm_phase(lds, g, S, E); }
    }
    SEAM(1);
    if (RUN(2)) {
        { pg8::Gemm g{(const bf16_t*)(ws + WS_MEMN), (const bf16_t*)(ws + WS_WK), D, D, D}; pg8::Order S; S.init(4, 16, 0, D, D);
          pg8::EpiB E{(bf16_t*)(ws + WS_KP), 2 * D, nullptr}; pg8::gemm_phase(lds, g, S, E); }
        phase_hgrn_local(p, lds);
    }
    SEAM(2);
    if (RUN(3)) {
        { pg8::Gemm g{(const bf16_t*)(ws + WS_KP), (const bf16_t*)(ws + WS_WQ), 2 * D, D, 512}; pg8::Order S; S.init(16, 8, 3, 2 * D, D);
          pg8::EpiB E{(bf16_t*)(ws + WS_WQK), D, nullptr}; pg8::gemm_phase(lds, g, S, E); }
        { pg8::Gemm g{(const bf16_t*)(ws + WS_WO), (const bf16_t*)(ws + WS_KP), D, 2 * D, 512}; pg8::Order S; S.init(32, 4, 4, D, 2 * D, 128);
          pg8::EpiB E{(bf16_t*)(ws + WS_WVO), 1024, nullptr}; pg8::gemm_phase(lds, g, S, E); }
        phase_hgrn_scan(p);
    }
    SEAM(3);
    if (RUN(4)) { phase_hgrn_out(p, lds); }
    SEAM(4);
    if (RUN(5)) {
        pg8::Gemm g{H, (const bf16_t*)(ws + WS_WOUT), D, D, D}; pg8::Order S; S.init(T / 256, D / 256, 0, D, D);
        pg8::EpiRes<false, false, true, true> E{p.x, nullptr, B0, rss2}; pg8::gemm_phase(lds, g, S, E);
    }
    SEAM(5);
    if (RUN(6)) {
        phase_ffn_weights(p, lds);
        pg8::Gemm g{B0, (const bf16_t*)(ws + WS_WQK), D, D, D}; pg8::Order S; S.init(T / 256, 4, 5, D, D);
        pg8::EpiSm E{B2, (LAS float*)(lds + STAGE_BYTES), rss2}; pg8::gemm_phase(lds, g, S, E);
    }
    SEAM(6);
    if (RUN(7)) {
        pg8::Gemm g{B2, (const bf16_t*)(ws + WS_WVO), 1024, 1024, 1024}; pg8::Order S; S.init(T / 256, D / 256, 6, 1024, 1024);
        pg8::EpiRes<true, false, true, true> E{B0, nullptr, B0, rss3}; pg8::gemm_phase(lds, g, S, E);
    }
    SEAM(7);
    if (RUN(8)) {
        pg8::Gemm g{B0, (const bf16_t*)(ws + WS_WGU), D, D, D}; pg8::Order S; S.init(T / 256, 2 * FF / 256, 0, D, D);
        pg8::EpiGu E{(bf16_t*)(ws + WS_ACT), rss3, p.ffn_conv_w, p.ffn_conv_b, (float*)(ws + WS_GF), (float*)(ws + WS_UF), (float*)(ws + WS_GL)}; pg8::gemm_phase(lds, g, S, E);
    }
    SEAM(8);
    if (RUN(9)) { phase_fixup(p); }
    SEAM(9);
    if (RUN(10)) {
        pg8::Gemm g{(const bf16_t*)(ws + WS_ACT), (const bf16_t*)(ws + WS_WDN), FF, FF, FF}; pg8::Order S; S.init(T / 256, D / 256, 0, FF, FF);
        pg8::EpiRes<true, false, true, false> E{B0, nullptr, B0, nullptr}; pg8::gemm_phase(lds, g, S, E);
    }
    SEAM(10);
    if (RUN(11)) { phase_final(p); }
}

extern "C" void kernel_launch(void* const* d_in, const int* in_sizes, int n_in, void* d_out, int out_size, void* d_ws, size_t ws_size, hipStream_t stream) {
    static int grid = 0;
    if (grid == 0) {
        if (n_in != 21 || ws_size < WS_END) { fprintf(stderr, "kernel_launch: unexpected inputs (%d) or workspace (%zu < %zu)\n", n_in, ws_size, (size_t)WS_END); grid = -1; return; }
        int dev = 0, cus = 0, per_cu = 0;
        hipGetDevice(&dev);
        hipDeviceGetAttribute(&cus, hipDeviceAttributeMultiprocessorCount, dev);
        if (hipFuncSetAttribute((const void*)fwd_megakernel, hipFuncAttributeMaxDynamicSharedMemorySize, LDS_BYTES) != hipSuccess) { fprintf(stderr, "kernel_launch: hipFuncSetAttribute failed\n"); grid = -1; return; }
        if (hipOccupancyMaxActiveBlocksPerMultiprocessor(&per_cu, (const void*)fwd_megakernel, 512, LDS_BYTES) != hipSuccess || per_cu < 1) { (void)hipGetLastError(); per_cu = 1; }
        grid = cus * per_cu;
    }
    if (grid < 0) return;
    Params p{};
    const float** f = (const float**)&p;
    for (int i = 0; i < 21; ++i) f[i] = (const float*)d_in[i];
    p.out = (float*)d_out; p.ws = (unsigned char*)d_ws;
#if MULTI_LAUNCH
    for (int ph = 0; ph < NPHASE; ++ph) {
        p.ph_lo = ph; p.ph_hi = ph;
        hipLaunchKernelGGL(fwd_megakernel, dim3(grid), dim3(512), LDS_BYTES, stream, p);
    }
#else
    p.ph_lo = 0; p.ph_hi = NPHASE - 1;
    if (hipMemsetAsync((char*)d_ws + WS_BAR, 0, XCD_BAR_WORDS * 4, stream) != hipSuccess) { fprintf(stderr, "kernel_launch: hipMemsetAsync failed\n"); return; }
    void* args[] = {&p};
    hipError_t e = hipLaunchCooperativeKernel((const void*)fwd_megakernel, dim3(grid), dim3(512), args, LDS_BYTES, stream);
    if (e != hipSuccess) fprintf(stderr, "cooperative launch failed: %s (grid %d)\n", hipGetErrorString(e), grid);
#endif
}
```

```cpp
#include <hip/hip_runtime.h>
#include <hip/hip_cooperative_groups.h>
#include <cstdio>
namespace cg = cooperative_groups;

#ifndef MULTI_LAUNCH
#define MULTI_LAUNCH 0
#endif

#ifndef ONLY_PHASE
#define ONLY_PHASE -1
#endif
#define PH_ON(k) (ONLY_PHASE < 0 || ONLY_PHASE == (k))

#define LAS __attribute__((address_space(3)))
typedef unsigned short bf16_t;
typedef short bf16x8 __attribute__((ext_vector_type(8)));
typedef float f32x4 __attribute__((ext_vector_type(4)));
typedef float f32x2 __attribute__((ext_vector_type(2)));
typedef unsigned u32x4 __attribute__((ext_vector_type(4)));
typedef unsigned u32x2 __attribute__((ext_vector_type(2)));

constexpr int T = 32768, D = 2048, SEQ = 8192;
constexpr int INC = 7168, PJ = 6144;
constexpr int FF = 5632;
constexpr float EPS = 1e-6f;
constexpr int NPHASE = 12;

constexpr size_t SZ_TD2 = (size_t)T * D * 2;
constexpr size_t WS_WIN = 0;
constexpr size_t WS_WOUT = WS_WIN + (size_t)INC * D * 2;
constexpr size_t WS_WQ = WS_WOUT + (size_t)D * D * 2;
constexpr size_t WS_WK = WS_WQ + (size_t)D * D * 2;
constexpr size_t WS_WV = WS_WK + (size_t)D * D * 2;
constexpr size_t WS_WO = WS_WV + (size_t)D * D * 2;
constexpr size_t WS_H = WS_WO + (size_t)D * D * 2;
constexpr size_t WS_B0 = WS_H + SZ_TD2;
constexpr size_t WS_B1 = WS_B0 + SZ_TD2;
constexpr size_t WS_B2 = WS_B1 + SZ_TD2;
constexpr size_t WS_LOGF = WS_B2 + SZ_TD2;
constexpr size_t WS_US = WS_LOGF + SZ_TD2;
constexpr size_t WS_MEMN = WS_US + (size_t)4096 * 16384 * 4;
constexpr size_t WS_KP = WS_MEMN + (size_t)1024 * D * 2;
constexpr size_t WS_VT = WS_KP + (size_t)1024 * D * 2;
constexpr size_t WS_DEC = WS_VT + (size_t)1024 * D * 2;
constexpr size_t WS_RSS2 = WS_DEC + (size_t)4096 * 128 * 4;
constexpr size_t WS_RSS3 = WS_RSS2 + (size_t)T * 4;
constexpr size_t WS_LB = WS_RSS3 + (size_t)T * 4;
constexpr size_t WS_WQK = WS_LB + 4096;
constexpr size_t WS_WVO = WS_WQK + (size_t)4 * 1024 * D * 2;
constexpr size_t WS_BAR = WS_WVO + (size_t)4 * D * 1024 * 2;
constexpr size_t WS_END = WS_BAR + 16384;
constexpr size_t WS_WGU = WS_US;
constexpr size_t WS_WDN = WS_US + (size_t)2 * FF * D * 2;
constexpr size_t WS_ACT = WS_B1;
constexpr size_t SZ_HALO = (size_t)512 * 2 * FF * 4;
constexpr size_t WS_GF = WS_H, WS_UF = WS_H + SZ_HALO, WS_GL = WS_H + 2 * SZ_HALO;
static_assert(WS_ACT + (size_t)T * FF * 2 <= WS_US, "act overlaps FFN weights");
static_assert(3 * SZ_HALO <= SZ_TD2, "halo");
static_assert(WS_END <= (size_t)1 << 30, "workspace");

constexpr int STAGE_BYTES = 131072;
constexpr int LDS_BYTES = STAGE_BYTES + 8192 + 16;

struct Params {
    const float* x; const float* mem; const float* hgrn_lb; const float* norm1_w; const float* w_in; const float* hgrn_norm_w; const float* sconv_w;
    const float* w_out; const float* norm2_w; const float* mem_norm_w; const float* wq; const float* wk; const float* wv; const float* wo;
    const float* norm3_w; const float* w_gate; const float* w_up; const float* ffn_conv_w; const float* ffn_conv_b; const float* w_down; const float* final_norm_w;
    float* out; unsigned char* ws; int ph_lo, ph_hi;
};

typedef __bf16 bf16x2_t __attribute__((ext_vector_type(2)));
__device__ __forceinline__ unsigned cvt_pk_bf16_c(float lo, float hi) { const f32x2 v = {lo, hi}; return __builtin_bit_cast(unsigned, __builtin_convertvector(v, bf16x2_t)); }
__device__ __forceinline__ unsigned cvt_pk_bf16(float lo, float hi) { unsigned r; asm volatile("v_cvt_pk_bf16_f32 %0, %1, %2" : "=v"(r) : "v"(lo), "v"(hi)); return r; }
__device__ __forceinline__ float bf_lo(unsigned u) { return __uint_as_float(u << 16); }
__device__ __forceinline__ float bf_hi(unsigned u) { return __uint_as_float(u & 0xffff0000u); }
__device__ __forceinline__ float silu_f(float v) { return v * __builtin_amdgcn_rcpf(1.0f + __expf(-v)); }
__device__ __forceinline__ float wave_sum(float v) {
#pragma unroll
    for (int o = 32; o >= 1; o >>= 1) v += __shfl_xor(v, o);
    return v;
}

namespace pg8 {
constexpr int BM = 256, BK = 64, HALF = 128, HTB = HALF * BK * 2, NXCD = 8, WGM = 8;
__host__ __device__ __forceinline__ int lds_byte(int r, int c) { const int st = (r >> 4) * 2 + (c >> 5), rr = r & 15, cc = c & 31, ob = rr * 64 + cc * 2; return st * 1024 + (ob ^ (((ob >> 9) & 1) << 5)); }
__host__ __device__ __forceinline__ void stage_rc(int b, int& R, int& C) { const int st = b / 1024, sb = b % 1024, swz = sb ^ (((sb >> 9) & 1) << 5); R = (st >> 1) * 16 + swz / 64; C = (st & 1) * 32 + (swz % 64) / 2; }
__host__ __device__ __forceinline__ int perm32(int rho) { const int n = rho >> 4, i = rho & 15; return 8 * (i >> 2) + 4 * n + (i & 3); }

struct Unit { size_t aoff, boff; int pm, pn; };
struct Gemm { const bf16_t* A; const bf16_t* Bt; int lda, ldb, K; };

struct Order {
    int nM, nN, nwg, G, c, mode; size_t lda2, ldb2;
    __device__ void init(int vc, int nM_, int nN_, int mode_, int lda, int ldb, int crot = 0) { nM = nM_; nN = nN_; nwg = nM * nN; G = gridDim.x; c = (int)((unsigned)(vc + crot) % gridDim.x); mode = mode_; lda2 = (size_t)lda * 2; ldb2 = (size_t)ldb * 2; }
    __device__ bool next(int i, Unit& u) const {
        const long L = (long)i * G + c; if (L >= nwg) return false;
        int wgid = (int)L; { const int q = nwg / NXCD, r = nwg % NXCD, xcd = wgid % NXCD, off = wgid / NXCD; wgid = (xcd < r ? xcd * (q + 1) : r * (q + 1) + (xcd - r) * q) + off; }
        const int nig = WGM * nN, gid = wgid / nig, fm = gid * WGM, gsz = (nM - fm) < WGM ? (nM - fm) : WGM;
        const int pm = fm + ((wgid % nig) % gsz), pn = (wgid % nig) / gsz;
        u.pm = pm; u.pn = pn;
        if (mode == 0) { u.aoff = (size_t)pm * 256 * lda2; u.boff = (size_t)pn * 256 * ldb2; }
        else if (mode == 3) { const int b = pm >> 2, h = pm & 3; u.aoff = (size_t)(b * 256) * lda2 + (size_t)h * 1024; u.boff = (size_t)pn * 256 * ldb2 + (size_t)h * 1024; }
        else if (mode == 4) { const int b = pm >> 3, nt_ = pm & 7, h = pn; u.aoff = (size_t)(nt_ * 256) * lda2 + (size_t)h * 1024; u.boff = (size_t)(b * 256) * ldb2 + (size_t)(2048 + h * 512) * 2; }
        else if (mode == 5) { const int b = pm >> 5; u.aoff = (size_t)pm * 256 * lda2; u.boff = (size_t)(b * 1024 + pn * 256) * ldb2; }
        else { const int b = pm >> 5; u.aoff = (size_t)pm * 256 * lda2; u.boff = (size_t)(b * 2048 + pn * 256) * ldb2; }
        return true;
    }
};

template <class Epi>
__device__ __forceinline__ void gemm_phase(LAS unsigned char* lds, const Gemm g, const Order& S, const Epi& E) {
    const int tid = threadIdx.x, wid = __builtin_amdgcn_readfirstlane(tid >> 6), lane = tid & 63, wr = wid >> 2, wc = wid & 3, fr = lane & 15, fq = lane >> 4;
    const int K = g.K, nt = K / BK;
    unsigned voffA[2], voffB[2];
#pragma unroll
    for (int i = 0; i < 2; ++i) { int R, C; stage_rc(tid * 16 + i * 8192, R, C); const int Rb = Epi::PERM ? ((R & ~31) + perm32(R & 31)) : R;
        voffA[i] = (unsigned)(R * g.lda + C) * 2u; voffB[i] = (unsigned)(Rb * g.ldb + C) * 2u; }
    const size_t kstep = (size_t)(BK * 2);
    const size_t hstepA = (size_t)HALF * g.lda * 2, hstepB = (size_t)HALF * g.ldb * 2;
    const unsigned ldsw = (unsigned)wid * 1024u;
    const int aoff = lds_byte(wr * 64 + fr, fq * 8), boff = lds_byte(wc * 32 + fr, fq * 8);
#define PG8_SA(b, h) (((b) * 2 + (h)) * HTB)
#define PG8_SB(b, h) ((4 + (b) * 2 + (h)) * HTB)
#define PG8_STAGE(bufoff, gbase, voff) do { _Pragma("unroll") for (int _i = 0; _i < 2; ++_i) \
        __builtin_amdgcn_global_load_lds((const unsigned*)((const char*)(gbase) + (voff)[_i]), (LAS unsigned*)(lds + (bufoff) + ldsw + _i * 8192), 16, 0, 0); } while (0)
#define PG8_LDA(dst, b, h) do { _Pragma("unroll") for (int m = 0; m < 4; ++m) _Pragma("unroll") for (int k = 0; k < 2; ++k) dst[m][k] = *(const LAS bf16x8*)(lds + PG8_SA(b, h) + aoff + m * 2048 + k * 1024); } while (0)
#define PG8_LDB(dst, b, h) do { _Pragma("unroll") for (int n = 0; n < 2; ++n) _Pragma("unroll") for (int k = 0; k < 2; ++k) dst[n][k] = *(const LAS bf16x8*)(lds + PG8_SB(b, h) + boff + n * 2048 + k * 1024); } while (0)
#define PG8_MMA(ai, bj, At, Bt) do { __builtin_amdgcn_s_setprio(1); _Pragma("unroll") for (int m = 0; m < 4; ++m) _Pragma("unroll") for (int n = 0; n < 2; ++n) _Pragma("unroll") for (int k = 0; k < 2; ++k) \
        acc[ai][bj][m][n] = __builtin_amdgcn_mfma_f32_16x16x32_bf16(Bt[n][k], At[m][k], acc[ai][bj][m][n], 0, 0, 0); __builtin_amdgcn_s_setprio(0); } while (0)
#define PG8_WAIT_V(n) asm volatile("s_waitcnt vmcnt(" #n ")" ::: "memory")
#define PG8_WAIT_L(n) asm volatile("s_waitcnt lgkmcnt(" #n ")" ::: "memory")
#define PG8_BAR __builtin_amdgcn_s_barrier()
#define PG8_SCHED __builtin_amdgcn_sched_barrier(0)
    Unit cur, nxt; int ui = 0;
    if (!S.next(0, cur)) return;
    f32x4 acc[2][2][4][2];
#pragma unroll
    for (int a = 0; a < 2; ++a)
#pragma unroll
        for (int b = 0; b < 2; ++b)
#pragma unroll
            for (int m = 0; m < 4; ++m)
#pragma unroll
                for (int n = 0; n < 2; ++n) acc[a][b][m][n] = (f32x4){0.f, 0.f, 0.f, 0.f};
    bf16x8 At[4][2], B0[2][2], B1[2][2];
    const char* cA = (const char*)g.A + cur.aoff; const char* cB = (const char*)g.Bt + cur.boff;
    PG8_STAGE(PG8_SB(0, 0), cB, voffB); PG8_STAGE(PG8_SB(0, 1), cB + hstepB, voffB); PG8_STAGE(PG8_SA(0, 0), cA, voffA); PG8_STAGE(PG8_SA(0, 1), cA + hstepA, voffA);
    if (wr == 1) PG8_BAR;
    PG8_WAIT_V(2); PG8_BAR;
    PG8_STAGE(PG8_SB(1, 0), cB + kstep, voffB); PG8_STAGE(PG8_SA(1, 0), cA + kstep, voffA); PG8_STAGE(PG8_SB(1, 1), cB + hstepB + kstep, voffB);
    PG8_WAIT_V(6); PG8_BAR;
    for (;;) {
        const bool has_next = S.next(ui + 1, nxt);
        const char* nA = has_next ? (const char*)g.A + nxt.aoff : cA; const char* nB = has_next ? (const char*)g.Bt + nxt.boff : cB;
        for (int t = 0; t < nt; t += 2) {
            const bool last = (t == nt - 2);
            const char* a1 = cA + (size_t)(t + 1) * kstep;
            const char* a2 = last ? nA : cA + (size_t)(t + 2) * kstep; const char* b2 = last ? nB : cB + (size_t)(t + 2) * kstep;
            const char* a3 = a2 + kstep; const char* b3 = b2 + kstep;
            PG8_LDB(B0, 0, 0); PG8_LDB(B1, 0, 1); PG8_SCHED; PG8_LDA(At, 0, 0); PG8_STAGE(PG8_SA(1, 1), a1 + hstepA, voffA);
            PG8_WAIT_V(8); PG8_WAIT_L(0); PG8_BAR; PG8_MMA(0, 0, At, B0); PG8_MMA(0, 1, At, B1); PG8_BAR; PG8_SCHED;
            PG8_LDA(At, 0, 1); PG8_STAGE(PG8_SB(0, 0), b2, voffB); PG8_STAGE(PG8_SB(0, 1), b2 + hstepB, voffB); PG8_STAGE(PG8_SA(0, 0), a2, voffA);
            PG8_WAIT_V(8); PG8_WAIT_L(0); PG8_BAR; PG8_MMA(1, 0, At, B0); PG8_MMA(1, 1, At, B1); PG8_BAR; PG8_SCHED;
            PG8_LDB(B0, 1, 0); PG8_LDB(B1, 1, 1); PG8_SCHED; PG8_LDA(At, 1, 0); PG8_STAGE(PG8_SA(0, 1), a2 + hstepA, voffA);
            PG8_WAIT_V(8); PG8_WAIT_L(0); PG8_BAR; PG8_MMA(0, 0, At, B0); PG8_MMA(0, 1, At, B1); PG8_BAR; PG8_SCHED;
            PG8_LDA(At, 1, 1); PG8_STAGE(PG8_SB(1, 0), b3, voffB); PG8_STAGE(PG8_SB(1, 1), b3 + hstepB, voffB); PG8_STAGE(PG8_SA(1, 0), a3, voffA);
            PG8_WAIT_V(8); PG8_WAIT_L(0); PG8_BAR; PG8_MMA(1, 0, At, B0); PG8_MMA(1, 1, At, B1); PG8_BAR; PG8_SCHED;
        }
        if (wr == 0) PG8_BAR;
        E(acc, cur, wr, wc, fr, fq);
        if (!has_next) break;
#pragma unroll
        for (int a = 0; a < 2; ++a)
#pragma unroll
            for (int b = 0; b < 2; ++b)
#pragma unroll
                for (int m = 0; m < 4; ++m)
#pragma unroll
                    for (int n = 0; n < 2; ++n) acc[a][b][m][n] = (f32x4){0.f, 0.f, 0.f, 0.f};
        cur = nxt; cA = nA; cB = nB; ++ui;
        if (wr == 1) PG8_BAR;
    }
    PG8_WAIT_V(0);
    PG8_BAR;
#undef PG8_SA
#undef PG8_SB
#undef PG8_STAGE
#undef PG8_LDA
#undef PG8_LDB
#undef PG8_MMA
#undef PG8_WAIT_V
#undef PG8_WAIT_L
#undef PG8_BAR
#undef PG8_SCHED
}

typedef f32x4 Acc[2][2][4][2];

struct EpiIn {
    static constexpr bool PERM = true;
    bf16_t* proj; float* logf; const float* lb;
    __device__ __forceinline__ void operator()(Acc& acc, const Unit& u, int wr, int wc, int fr, int fq) const {
        const int row0 = u.pm * 256 + wr * 64 + fr, sec = u.pn >> 2, colt = u.pn * 256 + wc * 32 + 8 * fq;
        if (sec == 1) {
#pragma unroll
            for (int bj = 0; bj < 2; ++bj) {
                const int c = colt + bj * 128 - 1024;
                const f32x4 l0 = *(const f32x4*)(lb + c), l1 = *(const f32x4*)(lb + c + 4);
#pragma unroll
                for (int ai = 0; ai < 2; ++ai)
#pragma unroll
                    for (int m = 0; m < 4; ++m) {
                        const size_t row = (size_t)(row0 + ai * 128 + m * 16);
                        f32x4 o0, o1;
#pragma unroll
                        for (int j = 0; j < 4; ++j) {
                            const float s0 = __builtin_amdgcn_rcpf(1.0f + __expf(-acc[ai][bj][m][0][j])), s1 = __builtin_amdgcn_rcpf(1.0f + __expf(-acc[ai][bj][m][1][j]));
                            o0[j] = __logf(l0[j] + (1.0f - l0[j]) * s0); o1[j] = __logf(l1[j] + (1.0f - l1[j]) * s1);
                        }
                        float* dst = logf + row * 1024 + c;
                        *(f32x4*)dst = o0; *(f32x4*)(dst + 4) = o1;
                    }
            }
        } else {
            const int cb = (sec == 0) ? colt : colt - 1024;
#pragma unroll
            for (int ai = 0; ai < 2; ++ai)
#pragma unroll
                for (int m = 0; m < 4; ++m) {
                    bf16_t* rowp = proj + (size_t)(row0 + ai * 128 + m * 16) * PJ + cb;
#pragma unroll
                    for (int bj = 0; bj < 2; ++bj) {
                        f32x4 v0 = acc[ai][bj][m][0], v1 = acc[ai][bj][m][1];
                        if (sec == 0) {
#pragma unroll
                            for (int j = 0; j < 4; ++j) { v0[j] = silu_f(v0[j]); v1[j] = silu_f(v1[j]); }
                        }
                        u32x4 w; w.x = cvt_pk_bf16(v0[0], v0[1]); w.y = cvt_pk_bf16(v0[2], v0[3]); w.z = cvt_pk_bf16(v1[0], v1[1]); w.w = cvt_pk_bf16(v1[2], v1[3]);
                        *(u32x4*)(rowp + bj * 128) = w;
                    }
                }
        }
    }
};

struct EpiB {
    static constexpr bool PERM = true;
    bf16_t* O; int ldc; const float* rss;
    __device__ __forceinline__ void operator()(Acc& acc, const Unit& u, int wr, int wc, int fr, int fq) const {
        const int row0 = u.pm * 256 + wr * 64 + fr, col0 = u.pn * 256 + wc * 32 + 8 * fq;
#pragma unroll
        for (int ai = 0; ai < 2; ++ai)
#pragma unroll
            for (int m = 0; m < 4; ++m) {
                const int row = row0 + ai * 128 + m * 16;
                const float s = rss ? rsqrtf(rss[row] * (1.0f / D) + EPS) : 1.0f;
                bf16_t* rowp = O + (size_t)row * ldc + col0;
#pragma unroll
                for (int bj = 0; bj < 2; ++bj) {
                    const f32x4 v0 = acc[ai][bj][m][0] * s, v1 = acc[ai][bj][m][1] * s;
                    u32x4 w; w.x = cvt_pk_bf16(v0[0], v0[1]); w.y = cvt_pk_bf16(v0[2], v0[3]); w.z = cvt_pk_bf16(v1[0], v1[1]); w.w = cvt_pk_bf16(v1[2], v1[3]);
                    *(u32x4*)(rowp + bj * 128) = w;
                }
            }
    }
};

template <bool XIN_BF16, bool OUT_F32, bool OUT_B, bool RSS> struct EpiRes {
    static constexpr bool PERM = true;
    const void* xin; float* xout; bf16_t* xb; float* rss;
    __device__ __forceinline__ void operator()(Acc& acc, const Unit& u, int wr, int wc, int fr, int fq) const {
        const int row0 = u.pm * 256 + wr * 64 + fr, col0 = u.pn * 256 + wc * 32 + 8 * fq;
#pragma unroll
        for (int ai = 0; ai < 2; ++ai) {
            f32x4 xi[4][2][2];
#pragma unroll
            for (int m = 0; m < 4; ++m)
#pragma unroll
                for (int bj = 0; bj < 2; ++bj) {
                    const size_t o = (size_t)(row0 + ai * 128 + m * 16) * D + col0 + bj * 128;
                    if (XIN_BF16) { const u32x4 r = *(const u32x4*)((const bf16_t*)xin + o);
                        xi[m][bj][0] = (f32x4){bf_lo(r.x), bf_hi(r.x), bf_lo(r.y), bf_hi(r.y)}; xi[m][bj][1] = (f32x4){bf_lo(r.z), bf_hi(r.z), bf_lo(r.w), bf_hi(r.w)}; }
                    else { xi[m][bj][0] = __builtin_nontemporal_load((const f32x4*)((const float*)xin + o)); xi[m][bj][1] = __builtin_nontemporal_load((const f32x4*)((const float*)xin + o + 4)); }
                }
#pragma unroll
            for (int m = 0; m < 4; ++m) {
                const size_t row = (size_t)(row0 + ai * 128 + m * 16);
                float ss = 0.f;
#pragma unroll
                for (int bj = 0; bj < 2; ++bj) {
                    const size_t o = row * D + col0 + bj * 128;
                    const f32x4 v0 = acc[ai][bj][m][0] + xi[m][bj][0], v1 = acc[ai][bj][m][1] + xi[m][bj][1];
                    if (OUT_F32) { *(f32x4*)(xout + o) = v0; *(f32x4*)(xout + o + 4) = v1; }
                    if (OUT_B) {
                        u32x4 w; w.x = cvt_pk_bf16(v0[0], v0[1]); w.y = cvt_pk_bf16(v0[2], v0[3]); w.z = cvt_pk_bf16(v1[0], v1[1]); w.w = cvt_pk_bf16(v1[2], v1[3]);
                        *(u32x4*)(xb + o) = w;
                        if (RSS) {
#pragma unroll
                            for (int j = 0; j < 4; ++j) ss += v0[j] * v0[j] + v1[j] * v1[j];
                        }
                    }
                }
                if (RSS) { ss += __shfl_xor(ss, 16); ss += __shfl_xor(ss, 32); if (fq == 0) atomicAdd(rss + row, ss); }
            }
        }
    }
};

struct EpiSm {
    static constexpr bool PERM = true;
    bf16_t* P; LAS float* xl; const float* rss;
    __device__ __forceinline__ void operator()(Acc& acc, const Unit& u, int wr, int wc, int fr, int fq) const {
        const float sc0 = 0.044194173824159216f * 1.4426950408889634f;
        const int rl0 = wr * 64 + fr;
        const int rowg0 = u.pm * 256 + wr * 64 + fr;
#pragma unroll
        for (int ai = 0; ai < 2; ++ai)
#pragma unroll
            for (int m = 0; m < 4; ++m) {
                float mx = -3.0e38f;
#pragma unroll
                for (int bj = 0; bj < 2; ++bj)
#pragma unroll
                    for (int n = 0; n < 2; ++n)
#pragma unroll
                        for (int j = 0; j < 4; ++j) mx = fmaxf(mx, acc[ai][bj][m][n][j]);
                mx = fmaxf(mx, __shfl_xor(mx, 16)); mx = fmaxf(mx, __shfl_xor(mx, 32));
                if (fq == 0) xl[(rl0 + ai * 128 + m * 16) * 4 + wc] = mx;
            }
        asm volatile("s_waitcnt lgkmcnt(0)" ::: "memory"); __builtin_amdgcn_s_barrier(); asm volatile("" ::: "memory");
#pragma unroll
        for (int ai = 0; ai < 2; ++ai)
#pragma unroll
            for (int m = 0; m < 4; ++m) {
                const int rl = rl0 + ai * 128 + m * 16;
                const f32x4 mm = *(const LAS f32x4*)(xl + rl * 4);
                const float sc = sc0 * rsqrtf(rss[rowg0 + ai * 128 + m * 16] * (1.0f / D) + EPS);
                const float M = fmaxf(fmaxf(mm[0], mm[1]), fmaxf(mm[2], mm[3])) * sc;
                float sum = 0.f;
#pragma unroll
                for (int bj = 0; bj < 2; ++bj)
#pragma unroll
                    for (int n = 0; n < 2; ++n)
#pragma unroll
                        for (int j = 0; j < 4; ++j) { const float pv = exp2f(acc[ai][bj][m][n][j] * sc - M); acc[ai][bj][m][n][j] = pv; sum += pv; }
                sum += __shfl_xor(sum, 16); sum += __shfl_xor(sum, 32);
                if (fq == 0) xl[1024 + rl * 4 + wc] = sum;
            }
        asm volatile("s_waitcnt lgkmcnt(0)" ::: "memory"); __builtin_amdgcn_s_barrier(); asm volatile("" ::: "memory");
        const int row0 = u.pm * 256 + wr * 64 + fr, col0 = u.pn * 256 + wc * 32 + 8 * fq;
#pragma unroll
        for (int ai = 0; ai < 2; ++ai)
#pragma unroll
            for (int m = 0; m < 4; ++m) {
                const int rl = rl0 + ai * 128 + m * 16;
                const f32x4 ss = *(const LAS f32x4*)(xl + 1024 + rl * 4);
                const float inv = 1.0f / (ss[0] + ss[1] + ss[2] + ss[3]);
                bf16_t* rowp = P + (size_t)(row0 + ai * 128 + m * 16) * 1024 + col0;
#pragma unroll
                for (int bj = 0; bj < 2; ++bj) {
                    const f32x4 v0 = acc[ai][bj][m][0] * inv, v1 = acc[ai][bj][m][1] * inv;
                    u32x4 w; w.x = cvt_pk_bf16(v0[0], v0[1]); w.y = cvt_pk_bf16(v0[2], v0[3]); w.z = cvt_pk_bf16(v1[0], v1[1]); w.w = cvt_pk_bf16(v1[2], v1[3]);
                    *(u32x4*)(rowp + bj * 128) = w;
                }
            }
    }
};

struct EpiGu {
    static constexpr bool PERM = true;
    bf16_t* act; const float* rss; const float* cw; const float* cbias; float* gf; float* uf; float* gl;
    __device__ __forceinline__ void operator()(Acc& acc, const Unit& u, int wr, int wc, int fr, int fq) const {
        const int row0 = u.pm * 256 + wr * 64 + fr, c0 = u.pn * 128 + wc * 32 + 8 * fq;
#pragma unroll
        for (int ai = 0; ai < 2; ++ai) {
            float rs[4];
#pragma unroll
            for (int m = 0; m < 4; ++m) rs[m] = rsqrtf(rss[row0 + ai * 128 + m * 16] * (1.0f / D) + EPS);
            const int blk = u.pm * 4 + ai * 2 + wr;
            unsigned pk[4][4];
#pragma unroll
            for (int n = 0; n < 2; ++n) {
                const f32x4 w0 = *(const f32x4*)(cw + c0 + 4 * n), w1 = *(const f32x4*)(cw + FF + c0 + 4 * n), w2 = *(const f32x4*)(cw + 2 * FF + c0 + 4 * n), bb = *(const f32x4*)(cbias + c0 + 4 * n);
#pragma unroll
                for (int jp = 0; jp < 2; ++jp) {
                    const f32x2 w0p = {w0[2 * jp], w0[2 * jp + 1]}, w1p = {w1[2 * jp], w1[2 * jp + 1]}, w2p = {w2[2 * jp], w2[2 * jp + 1]}, bbp = {bb[2 * jp], bb[2 * jp + 1]};
                    f32x2 gm[4], r1[4], r2[4];
#pragma unroll
                    for (int m = 0; m < 4; ++m) {
                        gm[m] = (f32x2){acc[ai][0][m][n][2 * jp], acc[ai][0][m][n][2 * jp + 1]} * rs[m];
                        r1[m].x = __int_as_float(__builtin_amdgcn_update_dpp(0, __float_as_int(gm[m].x), 0x121, 0xF, 0xF, false));
                        r1[m].y = __int_as_float(__builtin_amdgcn_update_dpp(0, __float_as_int(gm[m].y), 0x121, 0xF, 0xF, false));
                        r2[m].x = __int_as_float(__builtin_amdgcn_update_dpp(0, __float_as_int(gm[m].x), 0x122, 0xF, 0xF, false));
                        r2[m].y = __int_as_float(__builtin_amdgcn_update_dpp(0, __float_as_int(gm[m].y), 0x122, 0xF, 0xF, false));
                    }
#pragma unroll
                    for (int m = 0; m < 4; ++m) {
                        const f32x2 q1 = m >= 1 ? r1[m >= 1 ? m - 1 : 0] : (f32x2){0.f, 0.f}, q2 = m >= 1 ? r2[m >= 1 ? m - 1 : 0] : (f32x2){0.f, 0.f};
                        f32x2 p1, p2;
                        p1.x = (fr >= 1) ? r1[m].x : q1.x; p1.y = (fr >= 1) ? r1[m].y : q1.y;
                        p2.x = (fr >= 2) ? r2[m].x : q2.x; p2.y = (fr >= 2) ? r2[m].y : q2.y;
                        const f32x2 a = w2p * gm[m] + (w1p * p1 + (w0p * p2 + bbp));
                        const f32x2 na = a * (-1.4426950408889634f);
                        f32x2 den; den.x = __builtin_amdgcn_exp2f(na.x); den.y = __builtin_amdgcn_exp2f(na.y);
                        den = den + 1.0f;
                        f32x2 rc; rc.x = __builtin_amdgcn_rcpf(den.x); rc.y = __builtin_amdgcn_rcpf(den.y);
                        const f32x2 up = (f32x2){acc[ai][1][m][n][2 * jp], acc[ai][1][m][n][2 * jp + 1]} * rs[m];
                        const f32x2 ov = (a * rc) * up;
                        pk[m][2 * n + jp] = cvt_pk_bf16(ov.x, ov.y);
                    }
                }
            }
#pragma unroll
            for (int m = 0; m < 4; ++m) {
                const size_t row = (size_t)(row0 + ai * 128 + m * 16);
                if (!(m == 0 && fr < 2)) { u32x4 w; w.x = pk[m][0]; w.y = pk[m][1]; w.z = pk[m][2]; w.w = pk[m][3]; *(u32x4*)(act + row * FF + c0) = w; }
            }
            if (fr < 2) {
                const size_t o = ((size_t)blk * 2 + fr) * FF + c0;
                *(f32x4*)(gf + o) = acc[ai][0][0][0] * rs[0]; *(f32x4*)(gf + o + 4) = acc[ai][0][0][1] * rs[0];
                *(f32x4*)(uf + o) = acc[ai][1][0][0] * rs[0]; *(f32x4*)(uf + o + 4) = acc[ai][1][0][1] * rs[0];
            }
            if (fr >= 14) {
                const size_t o = ((size_t)blk * 2 + (fr - 14)) * FF + c0;
                *(f32x4*)(gl + o) = acc[ai][0][3][0] * rs[3]; *(f32x4*)(gl + o + 4) = acc[ai][0][3][1] * rs[3];
            }
        }
    }
};
}

__device__ __forceinline__ void transpose_tile(const float* __restrict__ src, int K, int N, bf16_t* __restrict__ dst, const float* __restrict__ scale, int k0, int n0, int rowmode, LAS float* tl) {
    const int tid = threadIdx.x;
    const int r = tid >> 6, c4 = (tid & 63) * 4;
    f32x4 v[8];
#pragma unroll
    for (int i = 0; i < 8; ++i) v[i] = __builtin_nontemporal_load((const f32x4*)(src + (size_t)(k0 + r + 8 * i) * N + n0 + c4));
#pragma unroll
    for (int i = 0; i < 8; ++i) {
        const int k = r + 8 * i;
        const float s = scale ? scale[k0 + k] : 1.0f;
        tl[k * 257 + c4 + 0] = v[i][0] * s; tl[k * 257 + c4 + 1] = v[i][1] * s; tl[k * 257 + c4 + 2] = v[i][2] * s; tl[k * 257 + c4 + 3] = v[i][3] * s;
    }
    __syncthreads();
    const int kg = (tid & 7) * 8;
#pragma unroll
    for (int q = 0; q < 4; ++q) {
        const int n = (tid >> 3) + 64 * q;
        float f[8];
#pragma unroll
        for (int j = 0; j < 8; ++j) f[j] = tl[(kg + j) * 257 + n];
        const int c = n0 + n;
        const int drow = rowmode == 0 ? c : (256 * (c >> 7) + (c & 127) + (rowmode == 2 ? 128 : 0));
        u32x4 w; w.x = cvt_pk_bf16(f[0], f[1]); w.y = cvt_pk_bf16(f[2], f[3]); w.z = cvt_pk_bf16(f[4], f[5]); w.w = cvt_pk_bf16(f[6], f[7]);
        *(u32x4*)(dst + (size_t)drow * K + k0 + kg) = w;
    }
    __syncthreads();
}

__device__ __forceinline__ void convert_tile(const float* __restrict__ src, int N, bf16_t* __restrict__ dst, const float* __restrict__ scale, int k0, int n0) {
    const int tid = threadIdx.x, r = tid >> 6, c4 = (tid & 63) * 4;
    f32x4 v[8];
#pragma unroll
    for (int i = 0; i < 8; ++i) v[i] = __builtin_nontemporal_load((const f32x4*)(src + (size_t)(k0 + r + 8 * i) * N + n0 + c4));
#pragma unroll
    for (int i = 0; i < 8; ++i) {
        const int k = k0 + r + 8 * i;
        const float sc = scale[k];
        u32x2 o; o.x = cvt_pk_bf16(v[i][0] * sc, v[i][1] * sc); o.y = cvt_pk_bf16(v[i][2] * sc, v[i][3] * sc);
        *(u32x2*)(dst + (size_t)k * N + n0 + c4) = o;
    }
}

__device__ __forceinline__ void rmsnorm_row_bf16(const float* __restrict__ src, const float* __restrict__ w, bf16_t* __restrict__ dst, int lane) {
    f32x4 v[8]; float ss = 0.f;
#pragma unroll
    for (int i = 0; i < 8; ++i) { v[i] = __builtin_nontemporal_load((const f32x4*)(src + i * 256 + lane * 4)); ss += v[i][0] * v[i][0] + v[i][1] * v[i][1] + v[i][2] * v[i][2] + v[i][3] * v[i][3]; }
    ss = wave_sum(ss);
    const float rstd = rsqrtf(ss * (1.0f / D) + EPS);
#pragma unroll
    for (int i = 0; i < 8; ++i) {
        const f32x4 g = *(const f32x4*)(w + i * 256 + lane * 4);
        u32x2 o; o.x = cvt_pk_bf16(v[i][0] * rstd * g[0], v[i][1] * rstd * g[1]); o.y = cvt_pk_bf16(v[i][2] * rstd * g[2], v[i][3] * rstd * g[3]);
        *(u32x2*)(dst + i * 256 + lane * 4) = o;
    }
}

__device__ void phase_prep(const Params& p, LAS unsigned char* lds) {
    const int tid = threadIdx.x, lane = tid & 63, w = tid >> 6;
    unsigned char* ws = p.ws;
    for (int t = blockIdx.x; t < 896 + 5 * 256; t += gridDim.x) {
        if (t < 896) { const int tk = t / 28, tn = t % 28; transpose_tile(p.w_in, D, INC, (bf16_t*)(ws + WS_WIN), nullptr, tk * 64, tn * 256, 0, (LAS float*)lds); }
        else { const int q = (t - 896) >> 8, r = (t - 896) & 255, tk = r >> 3, tn = r & 7;
            const float* src = q == 0 ? p.w_out : q == 1 ? p.wq : q == 2 ? p.wk : q == 3 ? p.wv : p.wo;
            const size_t off = q == 0 ? WS_WOUT : q == 1 ? WS_WQ : q == 2 ? WS_WK : q == 3 ? WS_WV : WS_WO;
            if (q == 1) convert_tile(src, D, (bf16_t*)(ws + off), p.norm2_w, tk * 64, tn * 256);
            else transpose_tile(src, D, D, (bf16_t*)(ws + off), nullptr, tk * 64, tn * 256, 0, (LAS float*)lds); }
    }
    for (int r = blockIdx.x * 8 + w; r < T + 1024; r += gridDim.x * 8) {
        if (r < T) rmsnorm_row_bf16(p.x + (size_t)r * D, p.norm1_w, (bf16_t*)(ws + WS_H) + (size_t)r * D, lane);
        else rmsnorm_row_bf16(p.mem + (size_t)(r - T) * D, p.mem_norm_w, (bf16_t*)(ws + WS_MEMN) + (size_t)(r - T) * D, lane);
    }
    for (int i = blockIdx.x * 512 + tid; i < 2 * T; i += gridDim.x * 512) ((float*)(ws + WS_RSS2))[i] = 0.f;
    for (int i = blockIdx.x * 512 + tid; i < 1024; i += gridDim.x * 512) { const float a0 = p.hgrn_lb[i], a1 = p.hgrn_lb[1024 + i]; ((float*)(ws + WS_LB))[i] = 1.0f / (1.0f + __expf(a1 - a0)); }
}

__device__ void phase_ffn_weights(const Params& p, LAS unsigned char* lds) {
    unsigned char* ws = p.ws;
    for (int t = blockIdx.x; t < 3 * 704; t += gridDim.x) {
        const int q = t / 704, r = t % 704;
        if (q < 2) { const int tk = r / 22, tn = r % 22; transpose_tile(q == 0 ? p.w_gate : p.w_up, D, FF, (bf16_t*)(ws + WS_WGU), p.norm3_w, tk * 64, tn * 256, 1 + q, (LAS float*)lds); }
        else { const int tk = r >> 3, tn = r & 7; transpose_tile(p.w_down, FF, D, (bf16_t*)(ws + WS_WDN), nullptr, tk * 64, tn * 256, 0, (LAS float*)lds); }
    }
}

#define LDS_BARRIER() do { asm volatile("s_waitcnt lgkmcnt(0)" ::: "memory"); __builtin_amdgcn_s_barrier(); asm volatile("" ::: "memory"); } while (0)
__device__ __forceinline__ int hgrn_item_of(int slot, bool deal, int c) {
    if (!deal) { const int item = blockIdx.x + slot * gridDim.x; return item < 4096 ? item : -1; }
    if (c < 64) return slot < 3 ? c + 256 * slot : -1;
    if (slot < 16) return c + 256 * slot;
    if (slot >= 21) return -1;
    const int r = (slot - 16) * 192 + (c - 64);
    return r < 832 ? (3 + (r >> 6)) * 256 + (r & 63) : -1;
}

__device__ void phase_hgrn_local(const Params& p, LAS unsigned char* lds, int vc) {
    const int tid = threadIdx.x, lane = tid & 63, w = tid >> 6, fr = lane & 15, fq = lane >> 4;
    LAS bf16_t* Ak = (LAS bf16_t*)(lds);
    LAS bf16_t* Vt = (LAS bf16_t*)(lds + 18432);
    LAS float* tots = (LAS float*)(lds + 36864);
    const float* logf = (const float*)(p.ws + WS_LOGF);
    const bf16_t* proj = (const bf16_t*)(p.ws + WS_B0);
    bf16_t* us = (bf16_t*)(p.ws + WS_US);
    float* dec = (float*)(p.ws + WS_DEC);
    const bool deal = (gridDim.x == 256);
    const int kp = lane, sg = w;
    f32x2 c[8]; unsigned vv[8];
#define HL_LOAD(ITEM) do { const int _it = (ITEM); const int _bh = _it >> 7, _n = _it & 127, _b = _bh >> 3, _h = _bh & 7; const size_t _t0 = (size_t)_b * SEQ + (size_t)_n * 64; \
        _Pragma("unroll") for (int i = 0; i < 8; ++i) { c[i] = __builtin_nontemporal_load((const f32x2*)(logf + (_t0 + 8 * sg + i) * 1024 + _h * 128 + 2 * kp)); vv[i] = __builtin_nontemporal_load((const unsigned*)(proj + (_t0 + 8 * sg + i) * PJ + 1024 + _h * 128 + 2 * kp)); } } while (0)
    int item = hgrn_item_of(0, deal, vc);
    if (item >= 0) HL_LOAD(item);
    for (int slot = 0; item >= 0; ++slot) {
        const int nitem = hgrn_item_of(slot + 1, deal, vc);
        f32x2 kk[8];
#pragma unroll
        for (int i = 0; i < 8; ++i) { kk[i].x = 1.0f - __expf(c[i].x); kk[i].y = 1.0f - __expf(c[i].y); }
#pragma unroll
        for (int i = 1; i < 8; ++i) c[i] += c[i - 1];
        *(LAS f32x2*)(tots + sg * 128 + 2 * kp) = c[7];
        LDS_BARRIER();
        f32x2 off = {0.f, 0.f}, tot = {0.f, 0.f};
#pragma unroll
        for (int g = 0; g < 8; ++g) { const f32x2 tv = *(const LAS f32x2*)(tots + g * 128 + 2 * kp); if (g < sg) off += tv; tot += tv; }
        float e0[8], e1[8];
#pragma unroll
        for (int i = 0; i < 8; ++i) { e0[i] = kk[i].x * __expf(tot.x - off.x - c[i].x); e1[i] = kk[i].y * __expf(tot.y - off.y - c[i].y); }
        u32x4 a0, a1, v0, v1;
        a0.x = cvt_pk_bf16(e0[0], e0[1]); a0.y = cvt_pk_bf16(e0[2], e0[3]); a0.z = cvt_pk_bf16(e0[4], e0[5]); a0.w = cvt_pk_bf16(e0[6], e0[7]);
        a1.x = cvt_pk_bf16(e1[0], e1[1]); a1.y = cvt_pk_bf16(e1[2], e1[3]); a1.z = cvt_pk_bf16(e1[4], e1[5]); a1.w = cvt_pk_bf16(e1[6], e1[7]);
        v0.x = (vv[0] & 0xffffu) | (vv[1] << 16); v0.y = (vv[2] & 0xffffu) | (vv[3] << 16); v0.z = (vv[4] & 0xffffu) | (vv[5] << 16); v0.w = (vv[6] & 0xffffu) | (vv[7] << 16);
        v1.x = (vv[0] >> 16) | (vv[1] & 0xffff0000u); v1.y = (vv[2] >> 16) | (vv[3] & 0xffff0000u); v1.z = (vv[4] >> 16) | (vv[5] & 0xffff0000u); v1.w = (vv[6] >> 16) | (vv[7] & 0xffff0000u);
        *(LAS u32x4*)(Ak + (2 * kp) * 72 + 8 * sg) = a0; *(LAS u32x4*)(Ak + (2 * kp + 1) * 72 + 8 * sg) = a1;
        *(LAS u32x4*)(Vt + (2 * kp) * 72 + 8 * sg) = v0; *(LAS u32x4*)(Vt + (2 * kp + 1) * 72 + 8 * sg) = v1;
        if (sg == 0) { f32x2 d; d.x = __expf(tot.x); d.y = __expf(tot.y); *(f32x2*)(dec + (size_t)item * 128 + 2 * kp) = d; }
        if (nitem >= 0) HL_LOAD(nitem);
        LDS_BARRIER();
        f32x4 acc[8];
#pragma unroll
        for (int kt = 0; kt < 8; ++kt) acc[kt] = (f32x4){0.f, 0.f, 0.f, 0.f};
#pragma unroll
        for (int ks = 0; ks < 2; ++ks) {
            const bf16x8 bq = *(const LAS bf16x8*)(Vt + (16 * w + fr) * 72 + 32 * ks + 8 * fq);
#pragma unroll
            for (int kt = 0; kt < 8; ++kt) { const bf16x8 a = *(const LAS bf16x8*)(Ak + (16 * kt + fr) * 72 + 32 * ks + 8 * fq); acc[kt] = __builtin_amdgcn_mfma_f32_16x16x32_bf16(a, bq, acc[kt], 0, 0, 0); }
        }
        bf16_t* dst = us + (size_t)item * 16384 + (16 * w + fr) * 128 + 4 * fq;
#pragma unroll
        for (int kt = 0; kt < 8; ++kt) { u32x2 o; o.x = cvt_pk_bf16_c(acc[kt][0], acc[kt][1]); o.y = cvt_pk_bf16_c(acc[kt][2], acc[kt][3]); *(u32x2*)(dst + 16 * kt) = o; }
        LDS_BARRIER();
        item = nitem;
    }
#undef HL_LOAD
}

__device__ void phase_hgrn_scan(const Params& p) {
    const bf16_t* us = (const bf16_t*)(p.ws + WS_US);
    bf16_t* sb = (bf16_t*)p.out;
    const float* dec = (const float*)(p.ws + WS_DEC);
    for (int idx = blockIdx.x * 512 + threadIdx.x; idx < 32 * 4096; idx += gridDim.x * 512) {
        const int bh = idx >> 12, e = (idx & 4095) * 4, k = e & 127;
        const bf16_t* base = us + (size_t)bh * 128 * 16384 + e;
        bf16_t* obase = sb + (size_t)bh * 128 * 16384 + e;
        const float* dbase = dec + (size_t)bh * 128 * 128 + k;
        f32x4 s = {0.f, 0.f, 0.f, 0.f};
        for (int n0 = 0; n0 < 128; n0 += 8) {
            u32x2 uu[8]; f32x4 dd[8];
#pragma unroll
            for (int i = 0; i < 8; ++i) { uu[i] = __builtin_nontemporal_load((const u32x2*)(base + (size_t)(n0 + i) * 16384)); dd[i] = *(const f32x4*)(dbase + (n0 + i) * 128); }
#pragma unroll
            for (int i = 0; i < 8; ++i) {
                u32x2 o; o.x = cvt_pk_bf16(s[0], s[1]); o.y = cvt_pk_bf16(s[2], s[3]);
                *(u32x2*)(obase + (size_t)(n0 + i) * 16384) = o;
                const f32x4 u4 = {bf_lo(uu[i].x), bf_hi(uu[i].x), bf_lo(uu[i].y), bf_hi(uu[i].y)};
                s = s * dd[i] + u4;
            }
        }
    }
}

__device__ void phase_hgrn_out(const Params& p, LAS unsigned char* lds) {
    const int tid = threadIdx.x, lane = tid & 63, w = tid >> 6, fr = lane & 15, fq = lane >> 4;
    LAS bf16_t* Qe = (LAS bf16_t*)(lds);
    LAS bf16_t* Ke = (LAS bf16_t*)(lds + 17408);
    LAS bf16_t* St = (LAS bf16_t*)(lds + 34816);
    LAS bf16_t* Vt = (LAS bf16_t*)(lds + 69632);
    LAS bf16_t* Pm = (LAS bf16_t*)(lds + 88064);
    LAS float* tots = (LAS float*)(lds + 97280);
    LAS float* ssq = (LAS float*)(lds + 101376);
    const float* logf = (const float*)(p.ws + WS_LOGF);
    const bf16_t* proj = (const bf16_t*)(p.ws + WS_B0);
    const bf16_t* us = (const bf16_t*)p.out;
    bf16_t* mix = (bf16_t*)(p.ws + WS_H);
    const int kp = lane, sg = w;
    f32x2 c[8]; unsigned vv[8], qv[8]; u32x2 sv[8];
#define HG_LOAD_PRE(ITEM) do { const int _it = (ITEM); const int _bh = _it >> 7, _n = _it & 127, _b = _bh >> 3, _h = _bh & 7; const size_t _t0 = (size_t)_b * SEQ + (size_t)_n * 64; \
        _Pragma("unroll") for (int i = 0; i < 8; ++i) { const size_t t = _t0 + 8 * sg + i; \
            c[i] = __builtin_nontemporal_load((const f32x2*)(logf + t * 1024 + _h * 128 + 2 * kp)); qv[i] = __builtin_nontemporal_load((const unsigned*)(proj + t * PJ + _h * 128 + 2 * kp)); vv[i] = __builtin_nontemporal_load((const unsigned*)(proj + t * PJ + 1024 + _h * 128 + 2 * kp)); } \
        _Pragma("unroll") for (int i = 0; i < 8; ++i) { const int idx = tid + 512 * i; sv[i] = __builtin_nontemporal_load((const u32x2*)(us + (size_t)_it * 16384 + (idx >> 5) * 128 + (idx & 31) * 4)); } } while (0)
    if ((int)blockIdx.x < 4096) HG_LOAD_PRE(blockIdx.x);
    for (int item = blockIdx.x; item < 4096; item += gridDim.x) {
        const int bh = item >> 7, n = item & 127, b = bh >> 3, h = bh & 7;
        const size_t t0 = (size_t)b * SEQ + (size_t)n * 64;
        f32x2 kk[8];
#pragma unroll
        for (int i = 0; i < 8; ++i) { kk[i].x = 1.0f - __expf(c[i].x); kk[i].y = 1.0f - __expf(c[i].y); }
#pragma unroll
        for (int i = 1; i < 8; ++i) c[i] += c[i - 1];
        *(LAS f32x2*)(tots + sg * 128 + 2 * kp) = c[7];
        LDS_BARRIER();
        f32x2 off = {0.f, 0.f}, tot = {0.f, 0.f};
#pragma unroll
        for (int g = 0; g < 8; ++g) { const f32x2 tv = *(const LAS f32x2*)(tots + g * 128 + 2 * kp); if (g < sg) off += tv; tot += tv; }
        const f32x2 ref = tot * 0.5f;
#pragma unroll
        for (int i = 0; i < 8; ++i) {
            const float bx = off.x + c[i].x - ref.x, by = off.y + c[i].y - ref.y;
            const int t = 8 * sg + i;
            *(LAS unsigned*)(Qe + t * 136 + 2 * kp) = cvt_pk_bf16(bf_lo(qv[i]) * __expf(bx), bf_hi(qv[i]) * __expf(by));
            *(LAS unsigned*)(Ke + t * 136 + 2 * kp) = cvt_pk_bf16(kk[i].x * __expf(-bx), kk[i].y * __expf(-by));
        }
        {
            u32x4 v0, v1;
            v0.x = (vv[0] & 0xffffu) | (vv[1] << 16); v0.y = (vv[2] & 0xffffu) | (vv[3] << 16); v0.z = (vv[4] & 0xffffu) | (vv[5] << 16); v0.w = (vv[6] & 0xffffu) | (vv[7] << 16);
            v1.x = (vv[0] >> 16) | (vv[1] & 0xffff0000u); v1.y = (vv[2] >> 16) | (vv[3] & 0xffff0000u); v1.z = (vv[4] >> 16) | (vv[5] & 0xffff0000u); v1.w = (vv[6] >> 16) | (vv[7] & 0xffff0000u);
            *(LAS u32x4*)(Vt + (2 * kp) * 72 + 8 * sg) = v0; *(LAS u32x4*)(Vt + (2 * kp + 1) * 72 + 8 * sg) = v1;
        }
        {
            const int k4 = (tid & 31) * 4;
            f32x4 tt = {0.f, 0.f, 0.f, 0.f};
#pragma unroll
            for (int g = 0; g < 8; ++g) tt += *(const LAS f32x4*)(tots + g * 128 + k4);
            const f32x4 er = {__expf(0.5f * tt[0]), __expf(0.5f * tt[1]), __expf(0.5f * tt[2]), __expf(0.5f * tt[3])};
#pragma unroll
            for (int i = 0; i < 8; ++i) {
                const int v = (tid >> 5) + 16 * i;
                u32x2 o; o.x = cvt_pk_bf16(bf_lo(sv[i].x) * er[0], bf_hi(sv[i].x) * er[1]); o.y = cvt_pk_bf16(bf_lo(sv[i].y) * er[2], bf_hi(sv[i].y) * er[3]);
                *(LAS u32x2*)(St + v * 136 + k4) = o;
            }
        }
        const int tb = w >> 1, hf = w & 1, tl = 16 * tb + fr;
        u32x2 gg[4];
#pragma unroll
        for (int i = 0; i < 4; ++i) gg[i] = __builtin_nontemporal_load((const u32x2*)(proj + (t0 + tl) * PJ + 2048 + h * 128 + 16 * (4 * hf + i) + 4 * fq));
        const int cc_ = h * 128 + (tid & 31) * 4, tr = tid >> 5;
        u32x2 za[6], zb[6], cbv[4];
#pragma unroll
        for (int r = 0; r < 6; ++r) {
            const int tt = 4 * tr + r - 2;
            if (tt < 0 && n == 0) { za[r] = (u32x2){0u, 0u}; zb[r] = (u32x2){0u, 0u}; }
            else { const bf16_t* rp = proj + (size_t)((long)t0 + tt) * PJ; za[r] = __builtin_nontemporal_load((const u32x2*)(rp + 4096 + cc_)); zb[r] = __builtin_nontemporal_load((const u32x2*)(rp + 5120 + cc_)); }
        }
#pragma unroll
        for (int i = 0; i < 4; ++i) cbv[i] = __builtin_nontemporal_load((const u32x2*)(proj + (t0 + 4 * tr + i) * PJ + 3072 + cc_));
        if (item + (int)gridDim.x < 4096) HG_LOAD_PRE(item + (int)gridDim.x);
        LDS_BARRIER();
#pragma unroll
        for (int s2 = 0; s2 < 2; ++s2) {
            const int st = 2 * hf + s2;
            f32x4 a4 = {0.f, 0.f, 0.f, 0.f};
            if (st <= tb) {
#pragma unroll
                for (int ks = 0; ks < 4; ++ks) {
                    const bf16x8 a = *(const LAS bf16x8*)(Ke + (16 * st + fr) * 136 + 32 * ks + 8 * fq);
                    const bf16x8 bq = *(const LAS bf16x8*)(Qe + tl * 136 + 32 * ks + 8 * fq);
                    a4 = __builtin_amdgcn_mfma_f32_16x16x32_bf16(a, bq, a4, 0, 0, 0);
                }
            }
            const int s0 = 16 * st + 4 * fq;
            u32x2 o; o.x = cvt_pk_bf16(s0 + 0 <= tl ? a4[0] : 0.f, s0 + 1 <= tl ? a4[1] : 0.f); o.y = cvt_pk_bf16(s0 + 2 <= tl ? a4[2] : 0.f, s0 + 3 <= tl ? a4[3] : 0.f);
            *(LAS u32x2*)(Pm + tl * 72 + s0) = o;
        }
        LDS_BARRIER();
        f32x4 ao[4];
#pragma unroll
        for (int i = 0; i < 4; ++i) ao[i] = (f32x4){0.f, 0.f, 0.f, 0.f};
#pragma unroll
        for (int ks = 0; ks < 4; ++ks) {
            const bf16x8 bq = *(const LAS bf16x8*)(Qe + tl * 136 + 32 * ks + 8 * fq);
#pragma unroll
            for (int i = 0; i < 4; ++i) { const bf16x8 a = *(const LAS bf16x8*)(St + (16 * (4 * hf + i) + fr) * 136 + 32 * ks + 8 * fq); ao[i] = __builtin_amdgcn_mfma_f32_16x16x32_bf16(a, bq, ao[i], 0, 0, 0); }
        }
#pragma unroll
        for (int ks = 0; ks < 2; ++ks) {
            const bf16x8 bq = *(const LAS bf16x8*)(Pm + tl * 72 + 32 * ks + 8 * fq);
#pragma unroll
            for (int i = 0; i < 4; ++i) { const bf16x8 a = *(const LAS bf16x8*)(Vt + (16 * (4 * hf + i) + fr) * 72 + 32 * ks + 8 * fq); ao[i] = __builtin_amdgcn_mfma_f32_16x16x32_bf16(a, bq, ao[i], 0, 0, 0); }
        }
        float ss = 0.f;
#pragma unroll
        for (int i = 0; i < 4; ++i)
#pragma unroll
            for (int j = 0; j < 4; ++j) ss += ao[i][j] * ao[i][j];
        ss += __shfl_xor(ss, 16); ss += __shfl_xor(ss, 32);
        if (fq == 0) ssq[tl * 2 + hf] = ss;
        LDS_BARRIER();
        const float rstd = rsqrtf((ssq[tl * 2] + ssq[tl * 2 + 1]) * (1.0f / 128.0f) + EPS);
#pragma unroll
        for (int i = 0; i < 4; ++i) {
            const int v0 = 16 * (4 * hf + i) + 4 * fq;
            const f32x4 nw = *(const f32x4*)(p.hgrn_norm_w + v0);
            u32x2 o;
            o.x = cvt_pk_bf16(ao[i][0] * rstd * nw[0] * silu_f(bf_lo(gg[i].x)), ao[i][1] * rstd * nw[1] * silu_f(bf_hi(gg[i].x)));
            o.y = cvt_pk_bf16(ao[i][2] * rstd * nw[2] * silu_f(bf_lo(gg[i].y)), ao[i][3] * rstd * nw[3] * silu_f(bf_hi(gg[i].y)));
            *(u32x2*)(mix + (t0 + tl) * D + h * 128 + v0) = o;
        }
        {
            const f32x4 w0 = *(const f32x4*)(p.sconv_w + cc_), w1 = *(const f32x4*)(p.sconv_w + 1024 + cc_), w2 = *(const f32x4*)(p.sconv_w + 2048 + cc_);
            f32x4 z[6];
#pragma unroll
            for (int r = 0; r < 6; ++r) z[r] = (f32x4){bf_lo(za[r].x) * bf_lo(zb[r].x), bf_hi(za[r].x) * bf_hi(zb[r].x), bf_lo(za[r].y) * bf_lo(zb[r].y), bf_hi(za[r].y) * bf_hi(zb[r].y)};
#pragma unroll
            for (int i = 0; i < 4; ++i) {
                const size_t t = t0 + 4 * tr + i;
                const f32x4 y = w0 * z[i] + w1 * z[i + 1] + w2 * z[i + 2];
                u32x2 o; o.x = cvt_pk_bf16(bf_lo(cbv[i].x) * y[0], bf_hi(cbv[i].x) * y[1]); o.y = cvt_pk_bf16(bf_lo(cbv[i].y) * y[2], bf_hi(cbv[i].y) * y[3]);
                *(u32x2*)(mix + t * D + 1024 + cc_) = o;
            }
        }
        LDS_BARRIER();
    }
#undef HG_LOAD_PRE
}

__device__ void phase_fixup(const Params& p) {
    const float* gf = (const float*)(p.ws + WS_GF); const float* uf = (const float*)(p.ws + WS_UF); const float* gl = (const float*)(p.ws + WS_GL);
    bf16_t* act = (bf16_t*)(p.ws + WS_ACT);
    const int per = FF / 4;
    for (int idx = blockIdx.x * 512 + threadIdx.x; idx < 512 * 2 * per; idx += gridDim.x * 512) {
        const int c = (idx % per) * 4, br = idx / per, r = br & 1, blk = br >> 1;
        const bool first = (blk & 127) == 0;
        const f32x4 zero = {0.f, 0.f, 0.f, 0.f};
        const f32x4 g0 = __builtin_nontemporal_load((const f32x4*)(gf + ((size_t)blk * 2 + r) * FF + c));
        f32x4 g1, g2;
        if (r == 0) { g1 = first ? zero : *(const f32x4*)(gl + ((size_t)(blk - 1) * 2 + 1) * FF + c); g2 = first ? zero : *(const f32x4*)(gl + ((size_t)(blk - 1) * 2) * FF + c); }
        else { g1 = *(const f32x4*)(gf + ((size_t)blk * 2) * FF + c); g2 = first ? zero : *(const f32x4*)(gl + ((size_t)(blk - 1) * 2 + 1) * FF + c); }
        const f32x4 uu = __builtin_nontemporal_load((const f32x4*)(uf + ((size_t)blk * 2 + r) * FF + c));
        const f32x4 w0 = *(const f32x4*)(p.ffn_conv_w + c), w1 = *(const f32x4*)(p.ffn_conv_w + FF + c), w2 = *(const f32x4*)(p.ffn_conv_w + 2 * FF + c), bb = *(const f32x4*)(p.ffn_conv_b + c);
        const f32x4 a = w2 * g0 + w1 * g1 + w0 * g2 + bb;
        u32x2 o; o.x = cvt_pk_bf16(silu_f(a[0]) * uu[0], silu_f(a[1]) * uu[1]); o.y = cvt_pk_bf16(silu_f(a[2]) * uu[2], silu_f(a[3]) * uu[3]);
        *(u32x2*)(act + ((size_t)blk * 64 + r) * FF + c) = o;
    }
}

__device__ void phase_final(const Params& p) {
    const int lane = threadIdx.x & 63, w = threadIdx.x >> 6;
    const bf16_t* x3 = (const bf16_t*)(p.ws + WS_B0);
    for (int r = blockIdx.x * 8 + w; r < T; r += gridDim.x * 8) {
        const bf16_t* src = x3 + (size_t)r * D;
        float* row = p.out + (size_t)r * D;
        u32x4 v[4]; float ss = 0.f;
#pragma unroll
        for (int i = 0; i < 4; ++i) {
            v[i] = __builtin_nontemporal_load((const u32x4*)(src + i * 512 + lane * 8));
            const float a0 = bf_lo(v[i].x), a1 = bf_hi(v[i].x), a2 = bf_lo(v[i].y), a3 = bf_hi(v[i].y), a4 = bf_lo(v[i].z), a5 = bf_hi(v[i].z), a6 = bf_lo(v[i].w), a7 = bf_hi(v[i].w);
            ss += a0 * a0 + a1 * a1 + a2 * a2 + a3 * a3 + a4 * a4 + a5 * a5 + a6 * a6 + a7 * a7;
        }
        ss = wave_sum(ss);
        const float rstd = rsqrtf(ss * (1.0f / D) + EPS);
#pragma unroll
        for (int i = 0; i < 4; ++i) {
            const f32x4 g0 = *(const f32x4*)(p.final_norm_w + i * 512 + lane * 8), g1 = *(const f32x4*)(p.final_norm_w + i * 512 + lane * 8 + 4);
            f32x4 o0 = {bf_lo(v[i].x), bf_hi(v[i].x), bf_lo(v[i].y), bf_hi(v[i].y)}, o1 = {bf_lo(v[i].z), bf_hi(v[i].z), bf_lo(v[i].w), bf_hi(v[i].w)};
            __builtin_nontemporal_store(o0 * rstd * g0, (f32x4*)(row + i * 512 + lane * 8)); __builtin_nontemporal_store(o1 * rstd * g1, (f32x4*)(row + i * 512 + lane * 8 + 4));
        }
    }
}

#define XB_TMO      128
#define XB_XCNT(j)  (256  + 64 * (j))
#define XB_XSUB(j)  (1280 + 64 * (j))
#define XB_XGEN(j)  (2304 + 64 * (j))
#define XB_TOP      3328
#define XB_TOPGEN   3392
#define XCD_BAR_WORDS 3456
#define XB_SPIN_CAP (1u << 21)
__device__ __forceinline__ unsigned xb_ld(unsigned* p)              { return __hip_atomic_load(p, __ATOMIC_RELAXED, __HIP_MEMORY_SCOPE_AGENT); }
__device__ __forceinline__ unsigned xb_add(unsigned* p, unsigned v) { return __hip_atomic_fetch_add(p, v, __ATOMIC_RELAXED, __HIP_MEMORY_SCOPE_AGENT); }
__device__ __forceinline__ unsigned xb_xcc_id() { return (unsigned)__builtin_amdgcn_s_getreg((3 << 11) | 20) & 0xFu; }
#define XB_SPIN(cond, bar) do { unsigned _sp = 0; while (cond) { __builtin_amdgcn_s_sleep(1); \
    if ((++_sp & 255u) == 0u) { if (xb_ld(&(bar)[XB_TMO])) break; if (_sp > XB_SPIN_CAP) { atomicAdd(&(bar)[XB_TMO], 1u); break; } } } } while (0)
struct XcdBarrier { unsigned* bar; unsigned x; volatile LAS unsigned* st; };
__device__ __forceinline__ XcdBarrier xcd_barrier_post(unsigned* bar, volatile LAS unsigned* st) {
    XcdBarrier b; b.bar = bar; b.x = xb_xcc_id(); b.st = st;
    if (threadIdx.x == 0) st[3] = xb_add(&bar[XB_XCNT(b.x)], 1u);
    return b;
}
__device__ __forceinline__ void xcd_barrier_complete(unsigned* bar, unsigned x, unsigned& nloc, unsigned& nx, unsigned& uni) {
    const unsigned G = gridDim.x * gridDim.y * gridDim.z;
    unsigned sum, cnt, mine, ok, sp = 0u;
    for (;;) {
        sum = 0u; cnt = 0u; mine = 0u; ok = 1u;
#pragma unroll
        for (unsigned j = 0; j < 16; ++j) { const unsigned c = xb_ld(&bar[XB_XCNT(j)]); sum += c; cnt += (c > 0u) ? 1u : 0u; mine = (j == x) ? c : mine; ok &= (c == (j < 8u ? G / 8u : 0u)) ? 1u : 0u; }
        if (sum == G) break;
        __builtin_amdgcn_s_sleep(1);
        if ((++sp & 255u) == 0u) { if (xb_ld(&bar[XB_TMO])) break; if (sp > XB_SPIN_CAP) { atomicAdd(&bar[XB_TMO], 1u); break; } }
    }
    nloc = mine > 0u ? mine : 1u; nx = cnt > 0u ? cnt : 1u; uni = (sum == G) ? ok : 0u;
}
__device__ __forceinline__ void xcd_barrier(const XcdBarrier& b) {
    asm volatile("s_waitcnt vmcnt(0)" ::: "memory");
    __syncthreads();
    if (threadIdx.x == 0) {
        unsigned* bar = b.bar;
        __builtin_amdgcn_s_waitcnt(0);
        unsigned nloc = b.st[0], nx = b.st[1];
        if (nloc == 0u) { unsigned uni; xcd_barrier_complete(bar, b.x, nloc, nx, uni); b.st[0] = nloc; b.st[1] = nx; b.st[2] = uni; }
        const unsigned old = xb_add(&bar[XB_XSUB(b.x)], 1u);
        const unsigned gen = old / nloc;
        if (old + 1u == (gen + 1u) * nloc) {
            __builtin_amdgcn_fence(__ATOMIC_RELEASE, "agent");
            asm volatile("s_waitcnt vmcnt(0)" ::: "memory");
            const unsigned og = xb_add(&bar[XB_TOP], 1u);
            const unsigned tg = og / nx;
            if (og + 1u == (tg + 1u) * nx) xb_add(&bar[XB_TOPGEN], 1u);
            else XB_SPIN(xb_ld(&bar[XB_TOPGEN]) == tg, bar);
            __builtin_amdgcn_fence(__ATOMIC_ACQUIRE, "agent");
            xb_add(&bar[XB_XGEN(b.x)], 1u);
            asm volatile("s_waitcnt vmcnt(0)" ::: "memory");
        } else {
            XB_SPIN(xb_ld(&bar[XB_XGEN(b.x)]) == gen, bar);
            __builtin_amdgcn_fence(__ATOMIC_ACQUIRE, "agent");
            asm volatile("s_waitcnt vmcnt(0)" ::: "memory");
        }
    }
    __syncthreads();
}

__global__ void __launch_bounds__(512) fwd_megakernel(Params p) {
    extern __shared__ __attribute__((aligned(16))) unsigned char smem[];
    LAS unsigned char* lds = (LAS unsigned char*)smem;
    unsigned char* ws = p.ws;
    bf16_t* const H = (bf16_t*)(ws + WS_H); bf16_t* const B0 = (bf16_t*)(ws + WS_B0); bf16_t* const B1 = (bf16_t*)(ws + WS_B1); bf16_t* const B2 = (bf16_t*)(ws + WS_B2);
    float* const rss2 = (float*)(ws + WS_RSS2); float* const rss3 = (float*)(ws + WS_RSS3);
#define RUN(k) (PH_ON(k) && p.ph_lo <= (k) && (k) <= p.ph_hi)
    volatile LAS unsigned* stw = (volatile LAS unsigned*)(lds + STAGE_BYTES + 8192);
    if (threadIdx.x < 4) stw[threadIdx.x] = 0u;
    __syncthreads();
    XcdBarrier xbar; xbar.bar = (unsigned*)(ws + WS_BAR); xbar.x = 0u; xbar.st = stw;
    if (p.ph_lo < p.ph_hi) xbar = xcd_barrier_post((unsigned*)(ws + WS_BAR), stw);
    if (p.ph_hi > 1000) cg::this_grid().sync();
#define SEAM(k) do { if (p.ph_lo <= (k) && (k) < p.ph_hi) xcd_barrier(xbar); } while (0)
    if (RUN(0)) { phase_prep(p, lds); }
    SEAM(0);
    int vcu = blockIdx.x;
    if (p.ph_lo < p.ph_hi && p.ph_lo == 0 && gridDim.x == 256 && stw[2] != 0u && stw[3] < 32u && xbar.x < 8u) vcu = (int)(stw[3] * 8u + xbar.x);
    vcu = __builtin_amdgcn_readfirstlane(vcu);
    if (RUN(1)) {
        { pg8::Gemm g{H, (const bf16_t*)(ws + WS_WIN), D, D, D}; pg8::Order S; S.init(vcu, T / 256, INC / 256, 0, D, D);
          pg8::EpiIn E{B0, (float*)(ws + WS_LOGF), (const float*)(ws + WS_LB)}; pg8::gemm_phase(lds, g, S, E); }
    }
    SEAM(1);
    if (RUN(2)) {
        { pg8::Gemm g{(const bf16_t*)(ws + WS_MEMN), (const bf16_t*)(ws + WS_WK), D, D, D}; pg8::Order S; S.init(vcu, 4, 16, 0, D, D);
          pg8::EpiB E{(bf16_t*)(ws + WS_KP), 2 * D, nullptr}; pg8::gemm_phase(lds, g, S, E); }
        phase_hgrn_local(p, lds, vcu);
    }
    SEAM(2);
    if (RUN(3)) {
        { pg8::Gemm g{(const bf16_t*)(ws + WS_KP), (const bf16_t*)(ws + WS_WQ), 2 * D, D, 512}; pg8::Order S; S.init(vcu, 16, 8, 3, 2 * D, D);
          pg8::EpiB E{(bf16_t*)(ws + WS_WQK), D, nullptr}; pg8::gemm_phase(lds, g, S, E); }
        { pg8::Gemm g{(const bf16_t*)(ws + WS_WO), (const bf16_t*)(ws + WS_KP), D, 2 * D, 512}; pg8::Order S; S.init(vcu, 32, 4, 4, D, 2 * D, 128);
          pg8::EpiB E{(bf16_t*)(ws + WS_WVO), 1024, nullptr}; pg8::gemm_phase(lds, g, S, E); }
        phase_hgrn_scan(p);
    }
    SEAM(3);
    if (RUN(4)) { phase_hgrn_out(p, lds); }
    SEAM(4);
    if (RUN(5)) {
        pg8::Gemm g{H, (const bf16_t*)(ws + WS_WOUT), D, D, D}; pg8::Order S; S.init(vcu, T / 256, D / 256, 0, D, D);
        pg8::EpiRes<false, false, true, true> E{p.x, nullptr, B0, rss2}; pg8::gemm_phase(lds, g, S, E);
    }
    SEAM(5);
    if (RUN(6)) {
        phase_ffn_weights(p, lds);
        pg8::Gemm g{B0, (const bf16_t*)(ws + WS_WQK), D, D, D}; pg8::Order S; S.init(vcu, T / 256, 4, 5, D, D);
        pg8::EpiSm E{B2, (LAS float*)(lds + STAGE_BYTES), rss2}; pg8::gemm_phase(lds, g, S, E);
    }
    SEAM(6);
    if (RUN(7)) {
        pg8::Gemm g{B2, (const bf16_t*)(ws + WS_WVO), 1024, 1024, 1024}; pg8::Order S; S.init(vcu, T / 256, D / 256, 6, 1024, 1024);
        pg8::EpiRes<true, false, true, true> E{B0, nullptr, B0, rss3}; pg8::gemm_phase(lds, g, S, E);
    }
    SEAM(7);
    if (RUN(8)) {
        pg8::Gemm g{B0, (const bf16_t*)(ws + WS_WGU), D, D, D}; pg8::Order S; S.init(vcu, T / 256, 2 * FF / 256, 0, D, D);
        pg8::EpiGu E{(bf16_t*)(ws + WS_ACT), rss3, p.ffn_conv_w, p.ffn_conv_b, (float*)(ws + WS_GF), (float*)(ws + WS_UF), (float*)(ws + WS_GL)}; pg8::gemm_phase(lds, g, S, E);
    }
    SEAM(8);
    if (RUN(9)) { phase_fixup(p); }
    SEAM(9);
    if (RUN(10)) {
        pg8::Gemm g{(const bf16_t*)(ws + WS_ACT), (const bf16_t*)(ws + WS_WDN), FF, FF, FF}; pg8::Order S; S.init(vcu, T / 256, D / 256, 0, FF, FF);
        pg8::EpiRes<true, false, true, false> E{B0, nullptr, B0, nullptr}; pg8::gemm_phase(lds, g, S, E);
    }
    SEAM(10);
    if (RUN(11)) { phase_final(p); }
}

extern "C" void kernel_launch(void* const* d_in, const int* in_sizes, int n_in, void* d_out, int out_size, void* d_ws, size_t ws_size, hipStream_t stream) {
    static int grid = 0;
    if (grid == 0) {
        if (n_in != 21 || ws_size < WS_END) { fprintf(stderr, "kernel_launch: unexpected inputs (%d) or workspace (%zu < %zu)\n", n_in, ws_size, (size_t)WS_END); grid = -1; return; }
        int dev = 0, cus = 0, per_cu = 0;
        hipGetDevice(&dev);
        hipDeviceGetAttribute(&cus, hipDeviceAttributeMultiprocessorCount, dev);
        if (hipFuncSetAttribute((const void*)fwd_megakernel, hipFuncAttributeMaxDynamicSharedMemorySize, LDS_BYTES) != hipSuccess) { fprintf(stderr, "kernel_launch: hipFuncSetAttribute failed\n"); grid = -1; return; }
        if (hipOccupancyMaxActiveBlocksPerMultiprocessor(&per_cu, (const void*)fwd_megakernel, 512, LDS_BYTES) != hipSuccess || per_cu < 1) { (void)hipGetLastError(); per_cu = 1; }
        grid = cus * per_cu;
    }
    if (grid < 0) return;
    Params p{};
    const float** f = (const float**)&p;
    for (int i = 0; i < 21; ++i) f[i] = (const float*)d_in[i];
    p.out = (float*)d_out; p.ws = (unsigned char*)d_ws;
#if MULTI_LAUNCH
    for (int ph = 0; ph < NPHASE; ++ph) {
        p.ph_lo = ph; p.ph_hi = ph;
        hipLaunchKernelGGL(fwd_megakernel, dim3(grid), dim3(512), LDS_BYTES, stream, p);
    }
#else
    p.ph_lo = 0; p.ph_hi = NPHASE - 1;
    if (hipMemsetAsync((char*)d_ws + WS_BAR, 0, XCD_BAR_WORDS * 4, stream) != hipSuccess) { fprintf(stderr, "kernel_launch: hipMemsetAsync failed\n"); return; }
    void* args[] = {&p};
    hipError_t e = hipLaunchCooperativeKernel((const void*)fwd_megakernel, dim3(grid), dim3(512), args, LDS_BYTES, stream);
    if (e != hipSuccess) fprintf(stderr, "cooperative launch failed: %s (grid %d)\n", hipGetErrorString(e), grid);
#endif
}
```
